# Optimizing an MI355X kernel written in HIP

```python
import math
import jax
import jax.numpy as jnp
from jax import lax

D_MODEL = 1024
BATCH = 4
SEQ = 4096
DEPTH = 4

N_MIXERS = 4
D_FF = 2816
NORM_EPS = 1e-6
CONV_K = 4

GDN_HEADS = 8
GDN_DK = 128
GDN_DV = 128
GDN_CHUNK = 64
GDN_QKV = 2 * GDN_HEADS * GDN_DK + GDN_HEADS * GDN_DV
GDN_PROJ = GDN_QKV + GDN_HEADS * GDN_DV + 2 * GDN_HEADS

RWKV_HEAD = 64
RWKV_HEADS = D_MODEL // RWKV_HEAD
RWKV_DECAY_LORA = 64
RWKV_AAA_LORA = 64
RWKV_GATE_LORA = 128
RWKV_GN_EPS = 64e-5

SSD_INNER = 2 * D_MODEL
SSD_HEADDIM = 64
SSD_HEADS = SSD_INNER // SSD_HEADDIM
SSD_GROUPS = 4
SSD_STATE = 128
SSD_CHUNK = 128
SSD_XBC = SSD_INNER + 2 * SSD_GROUPS * SSD_STATE
SSD_PROJ = SSD_INNER + SSD_XBC + SSD_HEADS
SSD_NORM_EPS = 1e-5

LRU_WIDTH = D_MODEL
LRU_BLOCKS = 4
LRU_BW = LRU_WIDTH // LRU_BLOCKS
LRU_C = 8.0

kernel_name = 'hybrid_macaron_gdn_rwkv7_ssd_rglru'


def _n_of_type(m):
    return (DEPTH - m + N_MIXERS - 1) // N_MIXERS


def rmsnorm(x, g, eps=NORM_EPS):
    xf = x.astype(jnp.float32)
    y = xf * lax.rsqrt(jnp.mean(xf * xf, axis=-1, keepdims=True) + eps)
    return (y * g.astype(jnp.float32)).astype(x.dtype)


def l2norm(x, eps=1e-6):
    return x * lax.rsqrt(jnp.sum(x * x, axis=-1, keepdims=True) + eps)


def swiglu(x, w_in, w_out):
    gate, up = jnp.split(x @ w_in, 2, axis=-1)
    return (jax.nn.silu(gate) * up) @ w_out


def causal_dwconv(x, w):
    taps, T = w.shape[0], x.shape[1]
    xp = jnp.pad(x, ((0, 0), (taps - 1, 0), (0, 0)))
    return sum(xp[:, j:j + T] * w[j] for j in range(taps))


def segsum(a):
    n = a.shape[-1]
    cs = jnp.cumsum(a, axis=-1)
    mask = jnp.tril(jnp.ones((n, n), dtype=bool))
    return jnp.where(mask, cs[..., :, None] - cs[..., None, :], -jnp.inf)


def gated_deltanet(x, w_in, conv_w, a_log, dt_bias, norm_w, w_out):
    Bsz, T, _ = x.shape
    H, DK, DV, C = GDN_HEADS, GDN_DK, GDN_DV, GDN_CHUNK
    f32 = jnp.float32
    N = T // C
    proj = x @ w_in
    qkv, z, b, a = jnp.split(proj, [GDN_QKV, GDN_QKV + H * DV, GDN_QKV + H * DV + H], axis=-1)
    qkv = jax.nn.silu(causal_dwconv(qkv, conv_w))
    q, k, v = jnp.split(qkv, [H * DK, 2 * H * DK], axis=-1)
    q = l2norm(q.reshape(Bsz, T, H, DK).astype(f32)) * DK ** -0.5
    k = l2norm(k.reshape(Bsz, T, H, DK).astype(f32))
    v = v.reshape(Bsz, T, H, DV).astype(f32)
    beta = jax.nn.sigmoid(b.astype(f32))
    g = -jnp.exp(a_log.astype(f32)) * jax.nn.softplus(a.astype(f32) + dt_bias.astype(f32))

    def chunk(t):
        return t.reshape(Bsz, N, C, H, -1).transpose(0, 3, 1, 2, 4)

    q, k, v = chunk(q), chunk(k), chunk(v)
    beta = beta.reshape(Bsz, N, C, H).transpose(0, 3, 1, 2)
    g = jnp.cumsum(g.reshape(Bsz, N, C, H).transpose(0, 3, 1, 2), axis=-1)
    causal = jnp.tril(jnp.ones((C, C), dtype=bool))
    strict = jnp.tril(jnp.ones((C, C), dtype=bool), -1)
    decay = jnp.exp(jnp.where(causal, g[..., :, None] - g[..., None, :], -jnp.inf))
    kk = jnp.einsum('bhncd,bhnsd->bhncs', k, k)
    lower = jnp.where(strict, kk * decay * beta[..., None], 0.0)
    eye = jnp.eye(C, dtype=f32)
    rhs = jnp.concatenate([v * beta[..., None], k * (beta * jnp.exp(g))[..., None]], axis=-1)
    sol = lax.linalg.triangular_solve(eye + lower, rhs, left_side=True, lower=True, unit_diagonal=True)
    u, w = sol[..., :DV], sol[..., DV:]
    qk = jnp.einsum('bhncd,bhnsd->bhncs', q, k) * decay
    q_dec = q * jnp.exp(g)[..., None]
    k_dec = k * jnp.exp(g[..., -1:] - g)[..., None]
    g_last = jnp.exp(g[..., -1])

    def step(S, inp):
        u_i, w_i, qk_i, qd_i, kd_i, gl_i = inp
        v_new = u_i - jnp.einsum('bhck,bhkv->bhcv', w_i, S)
        o = jnp.einsum('bhck,bhkv->bhcv', qd_i, S) + jnp.einsum('bhcs,bhsv->bhcv', qk_i, v_new)
        S = S * gl_i[..., None, None] + jnp.einsum('bhck,bhcv->bhkv', kd_i, v_new)
        return S, o

    xs = tuple(jnp.moveaxis(t, 2, 0) for t in (u, w, qk, q_dec, k_dec, g_last))
    S0 = jnp.zeros((Bsz, H, DK, DV), f32)
    _, o = lax.scan(step, S0, xs)
    o = o.transpose(1, 0, 3, 2, 4).reshape(Bsz, T, H, DV)
    o = rmsnorm(o, norm_w) * jax.nn.silu(z.reshape(Bsz, T, H, DV).astype(f32))
    return o.reshape(Bsz, T, H * DV).astype(x.dtype) @ w_out


def rwkv7_time_mix(x, mu, w_rkv, w0, w1, w2, a0, a1, a2, g1, g2, k_k, k_a, r_k, ln_w, ln_b, w_out):
    Bsz, T, D = x.shape
    H, N = RWKV_HEADS, RWKV_HEAD
    f32 = jnp.float32
    xx = jnp.pad(x, ((0, 0), (1, 0), (0, 0)))[:, :-1] - x
    xm = x[None] + xx[None] * mu[:, None, None, :]
    rkv = jnp.einsum('nbtd,nde->nbte', xm[:3], w_rkv).astype(f32)
    r, k, v = rkv[0], rkv[1], rkv[2]
    w_log = -jax.nn.softplus(-(w0 + jnp.tanh(xm[3] @ w1) @ w2).astype(f32)) - 0.5
    decay = jnp.exp(-jnp.exp(w_log))
    a = jax.nn.sigmoid((a0 + (xm[4] @ a1) @ a2).astype(f32))
    g = (jax.nn.sigmoid(xm[5] @ g1) @ g2).astype(f32)

    def heads(t):
        return t.reshape(Bsz, T, H, N)

    kk = l2norm(heads(k * k_k))
    k = k * (1.0 + (a - 1.0) * k_a)
    rh, kh, vh = heads(r), heads(k), heads(v)
    seq = tuple(jnp.moveaxis(t, 1, 0) for t in (rh, heads(decay), kh, vh, -kk, kk * heads(a)))

    def step(S, inp):
        r_t, w_t, k_t, v_t, a_t, b_t = inp
        sa = jnp.einsum('bhvk,bhk->bhv', S, a_t)
        S = S * w_t[:, :, None, :] + sa[..., None] * b_t[:, :, None, :] + v_t[..., None] * k_t[:, :, None, :]
        return S, jnp.einsum('bhvk,bhk->bhv', S, r_t)

    S0 = jnp.zeros((Bsz, H, N, N), f32)
    _, y = lax.scan(step, S0, seq)
    y = jnp.moveaxis(y, 0, 1)
    mean = jnp.mean(y, axis=-1, keepdims=True)
    var = jnp.mean(jnp.square(y - mean), axis=-1, keepdims=True)
    y = ((y - mean) * lax.rsqrt(var + RWKV_GN_EPS)).reshape(Bsz, T, D) * ln_w + ln_b
    bonus = jnp.sum(rh * kh * r_k, axis=-1, keepdims=True) * vh
    y = (y + bonus.reshape(Bsz, T, D)) * g
    return y.astype(x.dtype) @ w_out


def mamba2_ssd(x, w_in, conv_w, conv_b, dt_bias, a_log, d_skip, norm_w, w_out):
    Bsz, T, _ = x.shape
    G, NS, P, C = SSD_GROUPS, SSD_STATE, SSD_HEADDIM, SSD_CHUNK
    E = SSD_HEADS // G
    NC = T // C
    f32 = jnp.float32
    proj = x @ w_in
    z, xbc, dt = jnp.split(proj, [SSD_INNER, SSD_INNER + SSD_XBC], axis=-1)
    xbc = jax.nn.silu(causal_dwconv(xbc, conv_w) + conv_b)
    xs, Bm, Cm = jnp.split(xbc, [SSD_INNER, SSD_INNER + G * NS], axis=-1)
    dt = jax.nn.softplus(dt.astype(f32) + dt_bias.astype(f32))
    A = -jnp.exp(a_log.astype(f32))
    X = xs.astype(f32).reshape(Bsz, NC, C, G, E, P)
    Bc = Bm.astype(f32).reshape(Bsz, NC, C, G, NS)
    Cc = Cm.astype(f32).reshape(Bsz, NC, C, G, NS)
    Xdt = X * dt.reshape(Bsz, NC, C, G, E)[..., None]
    dA = (dt * A).reshape(Bsz, NC, C, G, E).transpose(0, 3, 4, 1, 2)
    A_cs = jnp.cumsum(dA, axis=-1)
    CB = jnp.einsum('bclgn,bcsgn->bgcls', Cc, Bc)
    scores = CB[:, :, None] * jnp.exp(segsum(dA))
    Y_diag = jnp.einsum('bgecls,bcsgep->bclgep', scores, Xdt)
    decay_states = jnp.exp(A_cs[..., -1:] - A_cs)
    states = jnp.einsum('bclgn,bgecl,bclgep->bcgepn', Bc, decay_states, Xdt)
    states = jnp.concatenate([jnp.zeros_like(states[:, :1]), states], axis=1)
    chunk_tot = jnp.pad(A_cs[..., -1], ((0, 0), (0, 0), (0, 0), (1, 0)))
    decay_chunk = jnp.exp(segsum(chunk_tot))
    prev_states = jnp.einsum('bgezc,bcgepn->bzgepn', decay_chunk, states)[:, :-1]
    Y_off = jnp.einsum('bclgn,bcgepn,bgecl->bclgep', Cc, prev_states, jnp.exp(A_cs))
    y = (Y_diag + Y_off + X * d_skip.astype(f32).reshape(G, E, 1)).reshape(Bsz, T, SSD_INNER)
    y = y * jax.nn.silu(z.astype(f32))
    y = rmsnorm(y.reshape(Bsz, T, G, SSD_INNER // G), norm_w.reshape(G, SSD_INNER // G), SSD_NORM_EPS)
    return y.reshape(Bsz, T, SSD_INNER).astype(x.dtype) @ w_out


def rglru_block(x, w_in, conv_w, conv_b, w_gates, b_gates, lam, w_out):
    Bsz, T, _ = x.shape
    f32 = jnp.float32
    gate, xb = jnp.split(x @ w_in, 2, axis=-1)
    u = (causal_dwconv(xb, conv_w) + conv_b).astype(f32)
    gates = jnp.einsum('btnc,ncd->btnd', u.reshape(Bsz, T, LRU_BLOCKS, LRU_BW), w_gates.astype(f32))
    gates = gates.reshape(Bsz, T, LRU_BLOCKS, 2, LRU_BW)
    r = jax.nn.sigmoid(gates[:, :, :, 0].reshape(Bsz, T, LRU_WIDTH) + b_gates[0])
    i = jax.nn.sigmoid(gates[:, :, :, 1].reshape(Bsz, T, LRU_WIDTH) + b_gates[1])
    log_a = -LRU_C * r * jax.nn.softplus(-lam.astype(f32))
    a = jnp.exp(log_a)
    bterm = jnp.sqrt(-jnp.expm1(2.0 * log_a)) * (i * u)

    def combine(p, q):
        a1, b1 = p
        a2, b2 = q
        return a1 * a2, a2 * b1 + b2

    _, h = lax.associative_scan(combine, (a, bterm), axis=1)
    y = jax.nn.gelu(gate.astype(f32)) * h
    return y.astype(x.dtype) @ w_out


def setup_inputs(seed: int = 0) -> dict:
    key = jax.random.key(seed)
    ks = iter(list(jax.random.split(key, 48)))
    f32 = jnp.float32

    def nrm(shape, scale):
        return scale * jax.random.normal(next(ks), shape, f32)

    def unif(shape, lo, hi):
        return jax.random.uniform(next(ks), shape, f32, lo, hi)

    def dt_bias(shape):
        dt = jnp.exp(unif(shape, math.log(1e-3), math.log(1e-1)))
        return dt + jnp.log(-jnp.expm1(-dt))

    nA, nB, nC, nD = (_n_of_type(m) for m in range(N_MIXERS))
    D = D_MODEL
    x = nrm((BATCH, SEQ, D), 1.0)
    norm_g = 1.0 + nrm((DEPTH, 6, D), 0.02)
    ffn_w_in = nrm((DEPTH, 2, D, 2 * D_FF), D ** -0.5)
    ffn_w_out = nrm((DEPTH, 2, D_FF, D), D_FF ** -0.5)
    gdn_w_in = nrm((nA, D, GDN_PROJ), D ** -0.5)
    gdn_conv_w = nrm((nA, CONV_K, GDN_QKV), CONV_K ** -0.5)
    gdn_a_log = jnp.log(unif((nA, GDN_HEADS), 1.0, 16.0))
    gdn_dt_bias = dt_bias((nA, GDN_HEADS))
    gdn_norm_w = 1.0 + nrm((nA, GDN_DV), 0.02)
    gdn_w_out = nrm((nA, GDN_HEADS * GDN_DV, D), (GDN_HEADS * GDN_DV) ** -0.5)
    rwkv_mu = unif((nB, 6, D), 0.0, 1.0)
    rwkv_w_rkv = nrm((nB, 3, D, D), D ** -0.5)
    rwkv_w0 = unif((nB, D), -6.5, -1.5)
    rwkv_w1 = nrm((nB, D, RWKV_DECAY_LORA), D ** -0.5)
    rwkv_w2 = nrm((nB, RWKV_DECAY_LORA, D), 0.1 * RWKV_DECAY_LORA ** -0.5)
    rwkv_a0 = nrm((nB, D), 0.1)
    rwkv_a1 = nrm((nB, D, RWKV_AAA_LORA), D ** -0.5)
    rwkv_a2 = nrm((nB, RWKV_AAA_LORA, D), 0.1 * RWKV_AAA_LORA ** -0.5)
    rwkv_g1 = nrm((nB, D, RWKV_GATE_LORA), D ** -0.5)
    rwkv_g2 = nrm((nB, RWKV_GATE_LORA, D), RWKV_GATE_LORA ** -0.5)
    rwkv_k_k = 0.85 + nrm((nB, D), 0.02)
    rwkv_k_a = 1.0 + nrm((nB, D), 0.02)
    rwkv_r_k = nrm((nB, RWKV_HEADS, RWKV_HEAD), 0.1)
    rwkv_ln_w = 1.0 + nrm((nB, D), 0.02)
    rwkv_ln_b = nrm((nB, D), 0.02)
    rwkv_w_out = nrm((nB, D, D), D ** -0.5)
    ssd_w_in = nrm((nC, D, SSD_PROJ), D ** -0.5)
    ssd_conv_w = nrm((nC, CONV_K, SSD_XBC), CONV_K ** -0.5)
    ssd_conv_b = nrm((nC, SSD_XBC), 0.02)
    ssd_dt_bias = dt_bias((nC, SSD_HEADS))
    ssd_a_log = jnp.log(unif((nC, SSD_HEADS), 1.0, 16.0))
    ssd_d = 1.0 + nrm((nC, SSD_HEADS), 0.1)
    ssd_norm_w = 1.0 + nrm((nC, SSD_INNER), 0.02)
    ssd_w_out = nrm((nC, SSD_INNER, D), SSD_INNER ** -0.5)
    lru_w_in = nrm((nD, D, 2 * LRU_WIDTH), D ** -0.5)
    lru_conv_w = nrm((nD, CONV_K, LRU_WIDTH), CONV_K ** -0.5)
    lru_conv_b = nrm((nD, LRU_WIDTH), 0.02)
    lru_w_gates = nrm((nD, LRU_BLOCKS, LRU_BW, 2 * LRU_BW), LRU_BW ** -0.5)
    lru_b_gates = nrm((nD, 2, LRU_WIDTH), 0.02)
    s = unif((nD, LRU_WIDTH), 0.9, 0.999) ** (1.0 / LRU_C)
    lru_lam = jnp.log(s) - jnp.log1p(-s)
    lru_w_out = nrm((nD, LRU_WIDTH, D), LRU_WIDTH ** -0.5)
    return {
        'x': x, 'norm_g': norm_g, 'ffn_w_in': ffn_w_in, 'ffn_w_out': ffn_w_out,
        'gdn_w_in': gdn_w_in, 'gdn_conv_w': gdn_conv_w, 'gdn_a_log': gdn_a_log,
        'gdn_dt_bias': gdn_dt_bias, 'gdn_norm_w': gdn_norm_w, 'gdn_w_out': gdn_w_out,
        'rwkv_mu': rwkv_mu, 'rwkv_w_rkv': rwkv_w_rkv, 'rwkv_w0': rwkv_w0, 'rwkv_w1': rwkv_w1,
        'rwkv_w2': rwkv_w2, 'rwkv_a0': rwkv_a0, 'rwkv_a1': rwkv_a1, 'rwkv_a2': rwkv_a2,
        'rwkv_g1': rwkv_g1, 'rwkv_g2': rwkv_g2, 'rwkv_k_k': rwkv_k_k, 'rwkv_k_a': rwkv_k_a,
        'rwkv_r_k': rwkv_r_k, 'rwkv_ln_w': rwkv_ln_w, 'rwkv_ln_b': rwkv_ln_b, 'rwkv_w_out': rwkv_w_out,
        'ssd_w_in': ssd_w_in, 'ssd_conv_w': ssd_conv_w, 'ssd_conv_b': ssd_conv_b,
        'ssd_dt_bias': ssd_dt_bias, 'ssd_a_log': ssd_a_log, 'ssd_d': ssd_d,
        'ssd_norm_w': ssd_norm_w, 'ssd_w_out': ssd_w_out,
        'lru_w_in': lru_w_in, 'lru_conv_w': lru_conv_w, 'lru_conv_b': lru_conv_b,
        'lru_w_gates': lru_w_gates, 'lru_b_gates': lru_b_gates, 'lru_lam': lru_lam,
        'lru_w_out': lru_w_out,
    }


def reference(x, norm_g, ffn_w_in, ffn_w_out,
              gdn_w_in, gdn_conv_w, gdn_a_log, gdn_dt_bias, gdn_norm_w, gdn_w_out,
              rwkv_mu, rwkv_w_rkv, rwkv_w0, rwkv_w1, rwkv_w2, rwkv_a0, rwkv_a1, rwkv_a2,
              rwkv_g1, rwkv_g2, rwkv_k_k, rwkv_k_a, rwkv_r_k, rwkv_ln_w, rwkv_ln_b, rwkv_w_out,
              ssd_w_in, ssd_conv_w, ssd_conv_b, ssd_dt_bias, ssd_a_log, ssd_d, ssd_norm_w, ssd_w_out,
              lru_w_in, lru_conv_w, lru_conv_b, lru_w_gates, lru_b_gates, lru_lam, lru_w_out):
    for i in range(DEPTH):
        m, j = i % N_MIXERS, i // N_MIXERS
        g = norm_g[i]
        x = x + 0.5 * rmsnorm(swiglu(rmsnorm(x, g[0]), ffn_w_in[i, 0], ffn_w_out[i, 0]), g[1])
        h = rmsnorm(x, g[2])
        if m == 0:
            h = gated_deltanet(h, gdn_w_in[j], gdn_conv_w[j], gdn_a_log[j], gdn_dt_bias[j],
                               gdn_norm_w[j], gdn_w_out[j])
        elif m == 1:
            h = rwkv7_time_mix(h, rwkv_mu[j], rwkv_w_rkv[j], rwkv_w0[j], rwkv_w1[j], rwkv_w2[j],
                               rwkv_a0[j], rwkv_a1[j], rwkv_a2[j], rwkv_g1[j], rwkv_g2[j],
                               rwkv_k_k[j], rwkv_k_a[j], rwkv_r_k[j], rwkv_ln_w[j], rwkv_ln_b[j],
                               rwkv_w_out[j])
        elif m == 2:
            h = mamba2_ssd(h, ssd_w_in[j], ssd_conv_w[j], ssd_conv_b[j], ssd_dt_bias[j],
                           ssd_a_log[j], ssd_d[j], ssd_norm_w[j], ssd_w_out[j])
        else:
            h = rglru_block(h, lru_w_in[j], lru_conv_w[j], lru_conv_b[j], lru_w_gates[j],
                            lru_b_gates[j], lru_lam[j], lru_w_out[j])
        x = x + rmsnorm(h, g[3])
        x = x + 0.5 * rmsnorm(swiglu(rmsnorm(x, g[4]), ffn_w_in[i, 1], ffn_w_out[i, 1]), g[5])
    return x
```

```cpp
#include <hip/hip_runtime.h>
#include <hip/hip_cooperative_groups.h>
#include <cstdio>
namespace cg = cooperative_groups;

#define LAS __attribute__((address_space(3)))
typedef unsigned short bf16_t;
typedef short bf16x8 __attribute__((ext_vector_type(8)));
typedef float f32x4 __attribute__((ext_vector_type(4)));
typedef unsigned u32x4 __attribute__((ext_vector_type(4)));
typedef unsigned u32x2 __attribute__((ext_vector_type(2)));

constexpr int M = 16384, T = 4096, NB = 4, D = 1024, DFF = 2816;
constexpr size_t MS = 16384;

constexpr size_t OFF_WF_IN = 0;
constexpr size_t SZ_WF_IN1 = 5632ull * 1024 * 2;
constexpr size_t OFF_WF_OUT = OFF_WF_IN + 8 * SZ_WF_IN1;
constexpr size_t SZ_WF_OUT1 = 1024ull * 2816 * 2;
constexpr size_t OFF_W_GDN_IN = OFF_WF_OUT + 8 * SZ_WF_OUT1;
constexpr size_t OFF_W_GDN_OUT = OFF_W_GDN_IN + 4352ull * 1024 * 2;
constexpr size_t OFF_W_RKV = OFF_W_GDN_OUT + 1024ull * 1024 * 2;
constexpr size_t OFF_W_L1 = OFF_W_RKV + 3 * 1024ull * 1024 * 2;
constexpr size_t OFF_W_L2 = OFF_W_L1 + 3 * 256ull * 1024 * 2;
constexpr size_t OFF_W_R_OUT = OFF_W_L2 + 3072ull * 256 * 2;
constexpr size_t OFF_W_SSD_IN = OFF_W_R_OUT + 1024ull * 1024 * 2;
constexpr size_t OFF_W_SSD_OUT = OFF_W_SSD_IN + 5376ull * 1024 * 2;
constexpr size_t OFF_W_LRU_IN = OFF_W_SSD_OUT + 1024ull * 2048 * 2;
constexpr size_t OFF_W_LRU_G = OFF_W_LRU_IN + 2048ull * 1024 * 2;
constexpr size_t OFF_W_LRU_OUT = OFF_W_LRU_G + 4 * 512ull * 256 * 2;
constexpr size_t OFF_XN = OFF_W_LRU_OUT + 1024ull * 1024 * 2;
constexpr size_t OFF_H = OFF_XN + MS * 1024 * 2;
constexpr size_t OFF_Y = OFF_H + MS * 2816 * 2;
constexpr size_t OFF_MX = OFF_Y + MS * 1024 * 4;
constexpr size_t G_PROJ = OFF_MX;
constexpr size_t G_BA = G_PROJ + MS * 4352 * 2;
constexpr size_t G_WB = G_BA + MS * 16 * 4;
constexpr size_t G_QD = G_WB + 2048ull * 64 * 128 * 2;
constexpr size_t G_QK = G_QD + 2048ull * 64 * 128 * 2;
constexpr size_t G_KDT = G_QK + 2048ull * 64 * 64 * 2;
constexpr size_t G_GL = G_KDT + 2048ull * 128 * 64 * 2;
constexpr size_t G_END = G_GL + 2048 * 4;
constexpr size_t R_XM = OFF_MX;
constexpr size_t R_K = R_XM + MS * 6144 * 2;
constexpr size_t R_V = R_K + MS * 1024 * 4;
constexpr size_t R_LOR = R_V + MS * 1024 * 4;
constexpr size_t R_END = R_LOR + MS * 256 * 2;
constexpr size_t S_PROJ = OFF_MX;
constexpr size_t S_DT = S_PROJ + MS * 5376 * 2;
constexpr size_t S_BCN = S_DT + MS * 32 * 4;
constexpr size_t S_XDTT = S_BCN + MS * 1024 * 2;
constexpr size_t S_BMT = S_XDTT + MS * 2048 * 2;
constexpr size_t S_DTV = S_BMT + MS * 512 * 2;
constexpr size_t S_ACS = S_DTV + MS * 32 * 4;
constexpr size_t S_END = S_ACS + MS * 32 * 4;
constexpr size_t L_PROJ = OFF_MX;
constexpr size_t L_U = L_PROJ + MS * 2048 * 4;
constexpr size_t L_AA = L_U + MS * 1024 * 2;
constexpr size_t L_BB = L_AA + MS * 1024 * 4;
constexpr size_t L_END = L_BB + MS * 1024 * 4;
constexpr size_t cmax(size_t a, size_t b) { return a > b ? a : b; }
constexpr size_t OFF_BAR = cmax(cmax(G_END, R_END), cmax(S_END, L_END));
constexpr size_t WS_NEED = OFF_BAR + 3456 * 4;

constexpr int LDS_BYTES = 160 * 1024;
constexpr int LDS_DESC_OFF = 128 * 1024;

struct Params { const float* in[41]; float* out; unsigned char* ws; };

__device__ __forceinline__ int otid() { int t = threadIdx.x; asm volatile("" : "+v"(t)); return t; }
__device__ __forceinline__ bf16_t f2bf(float f) { unsigned u = __float_as_uint(f); u += 0x7FFFu + ((u >> 16) & 1u); return (bf16_t)(u >> 16); }
__device__ __forceinline__ float bf2f(bf16_t b) { return __uint_as_float(((unsigned)b) << 16); }
__device__ __forceinline__ unsigned cvt_pk_bf16(float lo, float hi) { unsigned r; asm("v_cvt_pk_bf16_f32 %0, %1, %2" : "=v"(r) : "v"(lo), "v"(hi)); return r; }
__device__ __forceinline__ float lo_bf(unsigned u) { return __uint_as_float(u << 16); }
__device__ __forceinline__ float hi_bf(unsigned u) { return __uint_as_float(u & 0xFFFF0000u); }
__device__ __forceinline__ float sigmoidf_(float x) { return __builtin_amdgcn_rcpf(1.f + __expf(-x)); }
__device__ __forceinline__ float siluf_(float x) { return x * __builtin_amdgcn_rcpf(1.f + __expf(-x)); }
__device__ __forceinline__ float softplusf_(float x) { return fmaxf(x, 0.f) + log1pf(__expf(-fabsf(x))); }
__device__ __forceinline__ float tanhf_(float x) { float e = __expf(2.f * x); return 1.f - 2.f * __builtin_amdgcn_rcpf(1.f + e); }
__device__ __forceinline__ float gelu_tanh(float x) { return 0.5f * x * (1.f + tanhf_(0.7978845608028654f * (x + 0.044715f * x * x * x))); }
__device__ __forceinline__ float wave_sum(float v) {
#pragma unroll
    for (int o = 32; o > 0; o >>= 1) v += __shfl_xor(v, o, 64);
    return v;
}
template <int CTRL> __device__ __forceinline__ float dpp_f(float x) { return __builtin_bit_cast(float, __builtin_amdgcn_update_dpp(0, __builtin_bit_cast(int, x), CTRL, 0xF, 0xF, true)); }
__device__ __forceinline__ float dpp_sum16(float x) {
    x += dpp_f<0xB1>(x); x += dpp_f<0x4E>(x); x += dpp_f<0x141>(x); x += dpp_f<0x140>(x); return x;
}
__device__ __forceinline__ bf16x8 pack8(const float* v) {
    const u32x4 r = {cvt_pk_bf16(v[0], v[1]), cvt_pk_bf16(v[2], v[3]), cvt_pk_bf16(v[4], v[5]), cvt_pk_bf16(v[6], v[7])};
    return __builtin_bit_cast(bf16x8, r);
}
__device__ __forceinline__ bf16x8 pack8v(f32x4 a, f32x4 b) {
    const u32x4 r = {cvt_pk_bf16(a[0], a[1]), cvt_pk_bf16(a[2], a[3]), cvt_pk_bf16(b[0], b[1]), cvt_pk_bf16(b[2], b[3])};
    return __builtin_bit_cast(bf16x8, r);
}
#define LDS_BARRIER() do { asm volatile("s_waitcnt lgkmcnt(0)" ::: "memory"); __builtin_amdgcn_s_barrier(); asm volatile("" ::: "memory"); } while (0)
#define MFMA16(a, b, c) __builtin_amdgcn_mfma_f32_16x16x32_bf16((a), (b), (c), 0, 0, 0)

constexpr int BM = 256, BK = 64, HALF = 128, HTB = HALF * BK * 2, NXCD = 8, WGM = 8;
__device__ __forceinline__ int lds_byte(int r, int c) { const int st = (r >> 4) * 2 + (c >> 5), rr = r & 15, cc = c & 31, ob = rr * 64 + cc * 2; return st * 1024 + (ob ^ (((ob >> 9) & 1) << 5)); }
__device__ __forceinline__ void stage_rc(int b, int& R, int& C) { const int st = b / 1024, sb = b % 1024, swz = sb ^ (((sb >> 9) & 1) << 5); R = (st >> 1) * 16 + swz / 64; C = (st & 1) * 32 + (swz % 64) / 2; }
__device__ __forceinline__ int perm32(int rho) { const int n = rho >> 4, i = rho & 15; return 8 * (i >> 2) + 4 * n + (i & 3); }

enum { EPI_F32 = 0, EPI_SWIGLU = 1, EPI_BF16 = 2, EPI_LORA1 = 3, EPI_WAG = 4, EPI_LRU = 5 };
struct GDesc { const bf16_t* A; const bf16_t* Bt; void* C; int lda, ldb, ldc, nt, nM, nN, epi, perm, aux, aux2; float* side; };
struct Unit { int d, pm, pn; };
struct DescC { unsigned long long offA, offB, offC, offSide; int lda, ldb, ldc, nt, nM, nN, epi, perm, aux, aux2; };

__device__ __forceinline__ int rfl(int v) { return __builtin_amdgcn_readfirstlane(v); }
template <class P> __device__ __forceinline__ P* rflp(P* p) { unsigned long long u = (unsigned long long)p; unsigned lo = (unsigned)rfl((int)(unsigned)u), hi = (unsigned)rfl((int)(unsigned)(u >> 32)); return (P*)(__attribute__((address_space(1))) P*)(((unsigned long long)hi << 32) | lo); }
__device__ __forceinline__ Params load_params(const Params* q) {
    Params r;
#pragma unroll
    for (int i = 0; i < 41; ++i) r.in[i] = rflp(q->in[i]);
    r.out = rflp(q->out); r.ws = rflp(q->ws); return r;
}
__device__ __forceinline__ unsigned long long rfl64(unsigned long long u) { unsigned lo = (unsigned)rfl((int)(unsigned)u), hi = (unsigned)rfl((int)(unsigned)(u >> 32)); return ((unsigned long long)hi << 32) | lo; }
__device__ __forceinline__ GDesc load_desc(const DescC* q, unsigned char* ws) {
    GDesc d; d.A = (const bf16_t*)(ws + rfl64(q->offA)); d.Bt = (const bf16_t*)(ws + rfl64(q->offB)); d.C = (void*)(ws + rfl64(q->offC)); d.side = (float*)(ws + rfl64(q->offSide));
    d.lda = rfl(q->lda); d.ldb = rfl(q->ldb); d.ldc = rfl(q->ldc); d.nt = rfl(q->nt); d.nM = rfl(q->nM); d.nN = rfl(q->nN);
    d.epi = rfl(q->epi); d.perm = rfl(q->perm); d.aux = rfl(q->aux); d.aux2 = rfl(q->aux2); return d;
}
__device__ __forceinline__ bool next_unit(const DescC* descs, int nd, int i, Unit& u) {
    long L = (long)i * gridDim.x + blockIdx.x; int d = 0;
    for (; d < nd; ++d) { const int n = rfl(descs[d].nM * descs[d].nN); if (L < n) break; L -= n; }
    if (d >= nd) return false;
    const int nM = rfl(descs[d].nM), nN = rfl(descs[d].nN), nwg = nM * nN; int wgid = (int)L;
    { const int q = nwg / NXCD, r = nwg % NXCD, xcd = wgid % NXCD, off = wgid / NXCD; wgid = (xcd < r ? xcd * (q + 1) : r * (q + 1) + (xcd - r) * q) + off; }
    const int nig = WGM * nN, gid = wgid / nig, fm = gid * WGM, gsz = (nM - fm) < WGM ? (nM - fm) : WGM;
    u.d = d; u.pm = fm + ((wgid % nig) % gsz); u.pn = (wgid % nig) / gsz; return true;
}

__device__ __forceinline__ void gemm_epilogue(const f32x4 (&acc)[2][2][4][2], const GDesc& d, const Unit& u, int wr, int wc, int fr, int fq, const Params* lp_) {
    const int row0 = u.pm * BM + wr * 64 + fr;
    if (d.epi == EPI_F32) {
        float* C = (float*)d.C; const int col0 = u.pn * BM + wc * 32 + 4 * fq;
#pragma unroll
        for (int ai = 0; ai < 2; ++ai)
#pragma unroll
            for (int m = 0; m < 4; ++m) { float* rowp = C + (size_t)(row0 + ai * HALF + m * 16) * d.ldc + col0;
#pragma unroll
                for (int bj = 0; bj < 2; ++bj)
#pragma unroll
                    for (int n = 0; n < 2; ++n) *(f32x4*)(rowp + bj * HALF + n * 16) = acc[ai][bj][m][n]; }
    } else if (d.epi == EPI_SWIGLU) {
        bf16_t* C = (bf16_t*)d.C; const int col0 = u.pn * 128 + wc * 32 + 8 * fq;
#pragma unroll
        for (int ai = 0; ai < 2; ++ai)
#pragma unroll
            for (int m = 0; m < 4; ++m) {
                const f32x4 g0 = acc[ai][0][m][0], u0 = acc[ai][1][m][0], g1 = acc[ai][0][m][1], u1 = acc[ai][1][m][1];
                const u32x4 o = {cvt_pk_bf16(siluf_(g0[0]) * u0[0], siluf_(g0[1]) * u0[1]), cvt_pk_bf16(siluf_(g0[2]) * u0[2], siluf_(g0[3]) * u0[3]),
                                 cvt_pk_bf16(siluf_(g1[0]) * u1[0], siluf_(g1[1]) * u1[1]), cvt_pk_bf16(siluf_(g1[2]) * u1[2], siluf_(g1[3]) * u1[3])};
                *(u32x4*)(C + (size_t)(row0 + ai * HALF + m * 16) * d.ldc + col0) = o; }
    } else if (d.epi == EPI_BF16) {
        bf16_t* C = (bf16_t*)d.C; const int colt = wc * 32 + 8 * fq; const bool side = (u.pn == d.aux);
#pragma unroll
        for (int ai = 0; ai < 2; ++ai)
#pragma unroll
            for (int m = 0; m < 4; ++m) { const size_t row = (size_t)(row0 + ai * HALF + m * 16);
#pragma unroll
                for (int bj = 0; bj < 2; ++bj) { const f32x4 v0 = acc[ai][bj][m][0], v1 = acc[ai][bj][m][1];
                    const u32x4 o = {cvt_pk_bf16(v0[0], v0[1]), cvt_pk_bf16(v0[2], v0[3]), cvt_pk_bf16(v1[0], v1[1]), cvt_pk_bf16(v1[2], v1[3])};
                    *(u32x4*)(C + row * d.ldc + u.pn * BM + bj * HALF + colt) = o;
                    if (side && (bj * HALF + colt) < d.aux2) { float* sp = d.side + row * d.aux2 + bj * HALF + colt; *(f32x4*)sp = v0; *(f32x4*)(sp + 4) = v1; } } }
    } else if (d.epi == EPI_LORA1) {
        bf16_t* C = (bf16_t*)d.C; const int which = d.aux; const int ncol = which == 2 ? 128 : 64, coff = which * 64;
#pragma unroll
        for (int ai = 0; ai < 2; ++ai)
#pragma unroll
            for (int m = 0; m < 4; ++m) { const size_t row = (size_t)(row0 + ai * HALF + m * 16);
#pragma unroll
                for (int bj = 0; bj < 2; ++bj) { const int c0 = bj * HALF + wc * 32 + 8 * fq;
                    if (c0 < ncol) { float v[8];
#pragma unroll
                        for (int n = 0; n < 2; ++n)
#pragma unroll
                            for (int j = 0; j < 4; ++j) { float a = acc[ai][bj][m][n][j]; v[n * 4 + j] = which == 0 ? tanhf_(a) : (which == 1 ? a : sigmoidf_(a)); }
                        *(bf16x8*)(C + row * 256 + coff + c0) = pack8(v); } } }
    } else if (d.epi == EPI_WAG) {
        float* C = (float*)d.C; const int which = u.pn >> 2; const int cb = (u.pn & 3) * BM + wc * 32 + 4 * fq;
        const float* bp = which == 0 ? rflp(lp_->in[12]) : rflp(lp_->in[15]);
        f32x4 bv[2][2];
#pragma unroll
        for (int bj = 0; bj < 2; ++bj)
#pragma unroll
            for (int n = 0; n < 2; ++n) bv[bj][n] = which < 2 ? *(const f32x4*)(bp + cb + bj * HALF + n * 16) : (f32x4){0.f, 0.f, 0.f, 0.f};
#pragma unroll
        for (int ai = 0; ai < 2; ++ai)
#pragma unroll
            for (int m = 0; m < 4; ++m) { const size_t row = (size_t)(row0 + ai * HALF + m * 16);
#pragma unroll
                for (int bj = 0; bj < 2; ++bj)
#pragma unroll
                    for (int n = 0; n < 2; ++n) { const int c = cb + bj * HALF + n * 16; f32x4 v = acc[ai][bj][m][n]; const f32x4 bb = bv[bj][n];
                        if (which == 0) {
#pragma unroll
                            for (int j = 0; j < 4; ++j) { const float wl = -softplusf_(-(bb[j] + v[j])) - 0.5f; v[j] = __expf(-__expf(wl)); } }
                        else if (which == 1) {
#pragma unroll
                            for (int j = 0; j < 4; ++j) v[j] = sigmoidf_(bb[j] + v[j]); }
                        *(f32x4*)(C + (size_t)which * MS * 1024 + row * 1024 + c) = v; } }
    } else {
        const int blk = d.aux; const int chb = blk * 256 + u.pn * 128 + wc * 32 + 4 * fq;
        const float* b0 = rflp(lp_->in[38]); const float* b1 = b0 + 1024; const float* lam = rflp(lp_->in[39]);
        const bf16_t* U = (const bf16_t*)(rflp(lp_->ws) + L_U); float* AA = (float*)(rflp(lp_->ws) + L_AA); float* BB = (float*)(rflp(lp_->ws) + L_BB);
        f32x4 vb0[2], vb1[2], spl[2];
#pragma unroll
        for (int n = 0; n < 2; ++n) { vb0[n] = *(const f32x4*)(b0 + chb + n * 16); vb1[n] = *(const f32x4*)(b1 + chb + n * 16); spl[n] = *(const f32x4*)(lam + chb + n * 16); }
#pragma unroll
        for (int n = 0; n < 2; ++n)
#pragma unroll
            for (int j = 0; j < 4; ++j) spl[n][j] = -8.f * softplusf_(-spl[n][j]);
#pragma unroll
        for (int ai = 0; ai < 2; ++ai) {
            u32x2 uu[4][2];
#pragma unroll
            for (int m = 0; m < 4; ++m)
#pragma unroll
                for (int n = 0; n < 2; ++n) uu[m][n] = *(const u32x2*)(U + (size_t)(row0 + ai * HALF + m * 16) * 1024 + chb + n * 16);
#pragma unroll
            for (int m = 0; m < 4; ++m) { const size_t row = (size_t)(row0 + ai * HALF + m * 16); const unsigned rowb = ((((unsigned)row >> 12) << 18) + ((unsigned)row & 4095u)) << 4;
#pragma unroll
                for (int n = 0; n < 2; ++n) { const f32x4 rr = acc[ai][0][m][n], ii = acc[ai][1][m][n];
                    const u32x2 ux = uu[m][n]; const float uf[4] = {lo_bf(ux[0]), hi_bf(ux[0]), lo_bf(ux[1]), hi_bf(ux[1])};
                    f32x4 oa = {0.f, 0.f, 0.f, 0.f}, ob = {0.f, 0.f, 0.f, 0.f};
#pragma unroll
                    for (int j = 0; j < 4; ++j) { const float r = sigmoidf_(rr[j] + vb0[n][j]), ig = sigmoidf_(ii[j] + vb1[n][j]); const float la = r * spl[n][j];
                        oa[j] = __expf(la); ob[j] = sqrtf(fmaxf(-expm1f(2.f * la), 0.f)) * (ig * uf[j]); }
                    const unsigned gi = rowb + (((unsigned)(chb >> 4) + (unsigned)n) << 16) + (unsigned)(chb & 15);
                    *(f32x4*)(AA + gi) = oa; *(f32x4*)(BB + gi) = ob; } } }
    }
}

struct UP { const char* A; const char* B; unsigned lda2, ldb2, hA, hB, perm; };
__device__ __forceinline__ void unit_setup(UP& o, const GDesc& d, const Unit& u) {
    o.lda2 = (unsigned)d.lda * 2u; o.ldb2 = (unsigned)d.ldb * 2u; o.perm = (unsigned)d.perm;
    o.hA = (unsigned)HALF * o.lda2; o.hB = (unsigned)HALF * o.ldb2;
    o.A = (const char*)d.A + (size_t)u.pm * 2 * o.hA; o.B = (const char*)d.Bt + (size_t)u.pn * 2 * o.hB;
}

__device__ __forceinline__ void gemm_phase(LAS unsigned char* lds, const DescC* descs, int nd, const Params* lp_) {
    unsigned char* wsb = rflp(lp_->ws);
    const int tid = otid(), wid = __builtin_amdgcn_readfirstlane(tid >> 6), lane = tid & 63, wr = wid >> 2, wc = wid & 3, fr = lane & 15, fq = lane >> 4;
    int R0, C0, R1, C1; stage_rc(tid * 16, R0, C0); stage_rc(tid * 16 + 8192, R1, C1);
    const int Rp0 = (R0 & ~31) + perm32(R0 & 31), Rp1 = (R1 & ~31) + perm32(R1 & 31);
    const unsigned C0b = (unsigned)C0 * 2u, C1b = (unsigned)C1 * 2u;
    const size_t kstep = (size_t)(BK * 2);
    const unsigned ldsw = (unsigned)wid * 1024u;
    const int aoff = lds_byte(wr * 64 + fr, fq * 8), boff = lds_byte(wc * 32 + fr, fq * 8);
#define G_SA(b, h) (((b) * 2 + (h)) * HTB)
#define G_SB(b, h) ((4 + (b) * 2 + (h)) * HTB)
#define G_STAGE_A(bufoff, gbase, U) do { \
        __builtin_amdgcn_global_load_lds((const unsigned*)((const char*)(gbase) + ((unsigned)R0 * (U).lda2 + C0b)), (LAS unsigned*)(lds + (bufoff) + ldsw), 16, 0, 0); \
        __builtin_amdgcn_global_load_lds((const unsigned*)((const char*)(gbase) + ((unsigned)R1 * (U).lda2 + C1b)), (LAS unsigned*)(lds + (bufoff) + ldsw + 8192), 16, 0, 0); } while (0)
#define G_STAGE_B(bufoff, gbase, U) do { \
        __builtin_amdgcn_global_load_lds((const unsigned*)((const char*)(gbase) + ((unsigned)((U).perm ? Rp0 : R0) * (U).ldb2 + C0b)), (LAS unsigned*)(lds + (bufoff) + ldsw), 16, 0, 0); \
        __builtin_amdgcn_global_load_lds((const unsigned*)((const char*)(gbase) + ((unsigned)((U).perm ? Rp1 : R1) * (U).ldb2 + C1b)), (LAS unsigned*)(lds + (bufoff) + ldsw + 8192), 16, 0, 0); } while (0)
#define G_LDA(dst, b, h) do { _Pragma("unroll") for (int m = 0; m < 4; ++m) _Pragma("unroll") for (int k = 0; k < 2; ++k) dst[m][k] = *(const LAS bf16x8*)(lds + G_SA(b, h) + aoff + m * 2048 + k * 1024); } while (0)
#define G_LDB(dst, b, h) do { _Pragma("unroll") for (int n = 0; n < 2; ++n) _Pragma("unroll") for (int k = 0; k < 2; ++k) dst[n][k] = *(const LAS bf16x8*)(lds + G_SB(b, h) + boff + n * 2048 + k * 1024); } while (0)
#define G_MMA(ai, bj, At, Bt) do { __builtin_amdgcn_s_setprio(1); _Pragma("unroll") for (int m = 0; m < 4; ++m) _Pragma("unroll") for (int n = 0; n < 2; ++n) _Pragma("unroll") for (int k = 0; k < 2; ++k) \
        acc[ai][bj][m][n] = __builtin_amdgcn_mfma_f32_16x16x32_bf16(Bt[n][k], At[m][k], acc[ai][bj][m][n], 0, 0, 0); __builtin_amdgcn_s_setprio(0); } while (0)
#define G_WAIT_V(n) asm volatile("s_waitcnt vmcnt(" #n ")" ::: "memory")
#define G_WAIT_L(n) asm volatile("s_waitcnt lgkmcnt(" #n ")" ::: "memory")
#define G_BAR __builtin_amdgcn_s_barrier()
#define G_SCHED __builtin_amdgcn_sched_barrier(0)
    Unit cur, nxt; int ui = 0;
    if (!next_unit(descs, nd, 0, cur)) return;
    GDesc cd = load_desc(descs + cur.d, wsb);
    UP c, n2; unit_setup(c, cd, cur);
    int nt = cd.nt;
    f32x4 acc[2][2][4][2];
#pragma unroll
    for (int a = 0; a < 2; ++a)
#pragma unroll
        for (int b = 0; b < 2; ++b)
#pragma unroll
            for (int m = 0; m < 4; ++m)
#pragma unroll
                for (int n = 0; n < 2; ++n) acc[a][b][m][n] = (f32x4){0.f, 0.f, 0.f, 0.f};
    bf16x8 At[4][2], B0[2][2], B1[2][2];
    G_STAGE_B(G_SB(0, 0), c.B, c); G_STAGE_A(G_SA(0, 0), c.A, c); G_STAGE_B(G_SB(0, 1), c.B + c.hB, c); G_STAGE_A(G_SA(0, 1), c.A + c.hA, c);
    if (wr == 1) G_BAR;
    G_WAIT_V(4); G_BAR;
    G_STAGE_B(G_SB(1, 0), c.B + kstep, c); G_STAGE_A(G_SA(1, 0), c.A + kstep, c); G_STAGE_B(G_SB(1, 1), c.B + c.hB + kstep, c);
    G_WAIT_V(6); G_BAR;
    for (;;) {
        const bool has_next = next_unit(descs, nd, ui + 1, nxt);
        GDesc ndsc = cd;
        if (has_next) { ndsc = load_desc(descs + nxt.d, wsb); unit_setup(n2, ndsc, nxt); } else { n2 = c; }
        for (int t = 0; t < nt; t += 2) {
            const bool last = (t == nt - 2);
            const char* a1 = c.A + (size_t)(t + 1) * kstep;
            UP x = c; if (last) x = n2;
            const char* a2 = last ? n2.A : c.A + (size_t)(t + 2) * kstep; const char* b2 = last ? n2.B : c.B + (size_t)(t + 2) * kstep;
            const char* a3 = a2 + kstep; const char* b3 = b2 + kstep;
            G_LDB(B0, 0, 0); G_SCHED; G_LDA(At, 0, 0); G_STAGE_A(G_SA(1, 1), a1 + c.hA, c);
            G_WAIT_L(8); G_BAR; G_WAIT_L(0); G_MMA(0, 0, At, B0); G_BAR; G_SCHED;
            G_LDB(B1, 0, 1); G_STAGE_B(G_SB(0, 0), b2, x);
            G_BAR; G_WAIT_L(0); G_MMA(0, 1, At, B1); G_BAR;
            G_LDA(At, 0, 1); G_STAGE_A(G_SA(0, 0), a2, x);
            G_BAR; G_WAIT_L(0); G_MMA(1, 0, At, B0); G_BAR; G_SCHED;
            G_STAGE_B(G_SB(0, 1), b2 + x.hB, x);
            G_WAIT_V(6); G_BAR; G_MMA(1, 1, At, B1); G_BAR;
            G_LDB(B0, 1, 0); G_SCHED; G_LDA(At, 1, 0); G_STAGE_A(G_SA(0, 1), a2 + x.hA, x);
            G_WAIT_L(8); G_BAR; G_WAIT_L(0); G_MMA(0, 0, At, B0); G_BAR; G_SCHED;
            G_LDB(B1, 1, 1); G_STAGE_B(G_SB(1, 0), b3, x);
            G_BAR; G_WAIT_L(0); G_MMA(0, 1, At, B1); G_BAR;
            G_LDA(At, 1, 1); G_STAGE_A(G_SA(1, 0), a3, x);
            G_BAR; G_WAIT_L(0); G_MMA(1, 0, At, B0); G_BAR; G_SCHED;
            G_STAGE_B(G_SB(1, 1), b3 + x.hB, x);
            G_WAIT_V(6); G_BAR; G_MMA(1, 1, At, B1); G_BAR;
        }
        gemm_epilogue(acc, cd, cur, wr, wc, fr, fq, lp_);
        if (!has_next) break;
#pragma unroll
        for (int a = 0; a < 2; ++a)
#pragma unroll
            for (int b = 0; b < 2; ++b)
#pragma unroll
                for (int m = 0; m < 4; ++m)
#pragma unroll
                    for (int n = 0; n < 2; ++n) acc[a][b][m][n] = (f32x4){0.f, 0.f, 0.f, 0.f};
        cur = nxt; cd = ndsc; c = n2; nt = cd.nt; ++ui;
    }
    G_WAIT_V(0);
    if (wr == 0) G_BAR;
    G_BAR;
}

__device__ __forceinline__ void tr_job(float* tile, const float* src, int K, int Nsrc, int Ndst, bf16_t* dst, int ldd, int koff, int half, int rowoff, int bid, int nb) {
    const int tid = otid(); const int tk = K / 64, tn = (Ndst + 255) / 256, nt = tk * tn;
    const int kr = tid >> 6, n4 = (tid & 63) * 4;
    f32x4 v[8];
#define TR_LOAD(tt) do { const int kt_ = (tt) / tn, nt_ = (tt) % tn; const bool ok_ = (nt_ * 256 + n4) < Nsrc; \
        const float* sp_ = src + (size_t)(kt_ * 64 + kr) * Nsrc + (ok_ ? nt_ * 256 + n4 : 0); \
        _Pragma("unroll") for (int i = 0; i < 8; ++i) v[i] = *(const f32x4*)(sp_ + (size_t)(8 * i) * Nsrc); } while (0)
    if (bid < nt) TR_LOAD(bid);
    for (int t = bid; t < nt; t += nb) {
        const int kt = t / tn, ntile = t % tn, k0 = kt * 64, n0 = ntile * 256;
        const bool ok = (n0 + n4) < Nsrc;
        __syncthreads();
#pragma unroll
        for (int i = 0; i < 8; ++i) *(f32x4*)(tile + (kr + 8 * i) * 260 + n4) = ok ? v[i] : (f32x4){0.f, 0.f, 0.f, 0.f};
        __syncthreads();
        if (t + nb < nt) TR_LOAD(t + nb);
        const int n = tid >> 1, kh = (tid & 1) * 32, gn = n0 + n;
        if (gn < Ndst) {
            float o[32];
#pragma unroll
            for (int j = 0; j < 32; ++j) o[j] = tile[(kh + j) * 260 + n];
            int drow = gn;
            if (half) drow = gn < half ? (gn / 128) * 256 + (gn % 128) : ((gn - half) / 128) * 256 + 128 + ((gn - half) % 128);
            bf16_t* dp = dst + (size_t)(rowoff + drow) * ldd + koff + k0 + kh;
#pragma unroll
            for (int j = 0; j < 4; ++j) *(bf16x8*)(dp + j * 8) = pack8(o + j * 8);
        }
    }
#undef TR_LOAD
}

__device__ __forceinline__ float sumsq4(const f32x4 (&v)[4]) {
    float ss = 0.f;
#pragma unroll
    for (int i = 0; i < 4; ++i) ss += v[i][0] * v[i][0] + v[i][1] * v[i][1] + v[i][2] * v[i][2] + v[i][3] * v[i][3];
    return ss;
}
__device__ __forceinline__ void ph_rowpass(float* X, const float* Y, float scale, const float* ga, const float* gb, bf16_t* XN, bool has_gb) {
    const int tid_ = otid(); const int wid = tid_ >> 6, lane = tid_ & 63;
    f32x4 gav[4], gbv[4];
#pragma unroll
    for (int i = 0; i < 4; ++i) { gav[i] = *(const f32x4*)(ga + i * 256 + lane * 4); gbv[i] = *(const f32x4*)(gb + i * 256 + lane * 4); }
    f32x4 nx[4], ny[4];
    int row = blockIdx.x * 8 + wid;
#pragma unroll
    for (int i = 0; i < 4; ++i) { nx[i] = *(const f32x4*)(X + (size_t)row * 1024 + i * 256 + lane * 4); ny[i] = *(const f32x4*)(Y + (size_t)row * 1024 + i * 256 + lane * 4); }
    for (; row < M; row += gridDim.x * 8) {
        f32x4 xv[4], yv[4];
#pragma unroll
        for (int i = 0; i < 4; ++i) { xv[i] = nx[i]; yv[i] = ny[i]; }
        const int nrow = row + gridDim.x * 8;
        if (nrow < M) {
#pragma unroll
            for (int i = 0; i < 4; ++i) { nx[i] = *(const f32x4*)(X + (size_t)nrow * 1024 + i * 256 + lane * 4); ny[i] = *(const f32x4*)(Y + (size_t)nrow * 1024 + i * 256 + lane * 4); }
        }
        const float inv = rsqrtf(wave_sum(sumsq4(yv)) * (1.f / 1024.f) + 1e-6f) * scale;
#pragma unroll
        for (int i = 0; i < 4; ++i) { xv[i] += yv[i] * inv * gav[i]; __builtin_nontemporal_store(xv[i], (f32x4*)(X + (size_t)row * 1024 + i * 256 + lane * 4)); }
        if (has_gb) {
            const float inv2 = rsqrtf(wave_sum(sumsq4(xv)) * (1.f / 1024.f) + 1e-6f);
#pragma unroll
            for (int i = 0; i < 4; ++i) { const f32x4 o = xv[i] * inv2 * gbv[i];
                const u32x2 pk = {cvt_pk_bf16(o[0], o[1]), cvt_pk_bf16(o[2], o[3])}; *(u32x2*)(XN + (size_t)row * 1024 + i * 256 + lane * 4) = pk; }
        }
    }
}
__device__ __forceinline__ void ph_firstnorm(const float* xin, float* X, const float* gb, bf16_t* XN) {
    const int tid_ = otid(); const int wid = tid_ >> 6, lane = tid_ & 63;
    for (int row = blockIdx.x * 8 + wid; row < M; row += gridDim.x * 8) {
        f32x4 xv[4];
#pragma unroll
        for (int i = 0; i < 4; ++i) { xv[i] = *(const f32x4*)(xin + (size_t)row * 1024 + i * 256 + lane * 4); *(f32x4*)(X + (size_t)row * 1024 + i * 256 + lane * 4) = xv[i]; }
        const float inv2 = rsqrtf(wave_sum(sumsq4(xv)) * (1.f / 1024.f) + 1e-6f);
#pragma unroll
        for (int i = 0; i < 4; ++i) { const f32x4 g = *(const f32x4*)(gb + i * 256 + lane * 4); const f32x4 o = xv[i] * inv2 * g;
            const u32x2 pk = {cvt_pk_bf16(o[0], o[1]), cvt_pk_bf16(o[2], o[3])}; *(u32x2*)(XN + (size_t)row * 1024 + i * 256 + lane * 4) = pk; }
    }
}

__device__ __forceinline__ void ph_gdn_prep(unsigned char* shm, const Params* lp_) {
    float* qs = (float*)shm; float* ks = qs + 64 * 132; float* vs = ks + 64 * 132; float* Ls = vs + 64 * 132; float* beta = Ls + 64 * 68; float* gc = beta + 64; float* eg = gc + 64;
    const int tid = otid(), wid = tid >> 6, lane = tid & 63;
    const bf16_t* PROJ = (const bf16_t*)(rflp(lp_->ws) + G_PROJ); const float* BA = (const float*)(rflp(lp_->ws) + G_BA);
    float* U = (float*)(rflp(lp_->ws) + OFF_Y); bf16_t* Wb = (bf16_t*)(rflp(lp_->ws) + G_WB); bf16_t* QD = (bf16_t*)(rflp(lp_->ws) + G_QD); bf16_t* QK = (bf16_t*)(rflp(lp_->ws) + G_QK); bf16_t* KDT = (bf16_t*)(rflp(lp_->ws) + G_KDT); float* GL = (float*)(rflp(lp_->ws) + G_GL);
    const float* convw = rflp(lp_->in[5]); const float* a_log = rflp(lp_->in[6]); const float* dtb = rflp(lp_->in[7]);
    const int hfix = blockIdx.x & 7;
    const int cq = tid % 96, rg = tid / 96, seg = cq >> 5, col = (cq & 31) * 4; const int ch = seg * 1024 + hfix * 128 + col; const int r0 = rg * 13;
    u32x2 xw[16]; f32x4 cw[4]; float nbb = 0.f, naa = 0.f;
#pragma unroll
    for (int j = 0; j < 4; ++j) cw[j] = (tid < 480) ? *(const f32x4*)(convw + j * 3072 + ch) : (f32x4){0.f, 0.f, 0.f, 0.f};
    const float alh = -__expf(a_log[hfix]), dth = dtb[hfix];
#define GP_LOAD(tk_) do { const int n_ = ((tk_) >> 3) & 63, b_ = (tk_) >> 9; const int t0_ = n_ * 64; \
        if (tid < 480) { _Pragma("unroll") for (int i = 0; i < 16; ++i) { const int tt = t0_ + r0 - 3 + i; const int rl = r0 - 3 + i; xw[i] = (u32x2){0u, 0u}; \
            if (tt >= 0 && rl < 64) xw[i] = *(const u32x2*)(PROJ + ((size_t)b_ * T + tt) * 4352 + ch); } } \
        if (tid < 64) { nbb = BA[((size_t)b_ * T + t0_ + tid) * 16 + hfix]; naa = BA[((size_t)b_ * T + t0_ + tid) * 16 + 8 + hfix]; } } while (0)
    if ((int)blockIdx.x < 2048) GP_LOAD(blockIdx.x);
    for (int task = blockIdx.x; task < 2048; task += gridDim.x) {
        const int h = hfix, n = (task >> 3) & 63, b = task >> 9; const int t0 = n * 64; const size_t rowb = (size_t)b * T + t0;
        (void)rowb; (void)t0;
        LDS_BARRIER();
        if (tid < 480) {
            float* dst = (seg == 0 ? qs : (seg == 1 ? ks : vs));
#pragma unroll
            for (int i = 0; i < 13; ++i) { if (r0 + i < 64) { f32x4 a = {0.f, 0.f, 0.f, 0.f};
#pragma unroll
                for (int j = 0; j < 4; ++j) { const u32x2 xv = xw[i + j]; a[0] += cw[j][0] * lo_bf(xv[0]); a[1] += cw[j][1] * hi_bf(xv[0]); a[2] += cw[j][2] * lo_bf(xv[1]); a[3] += cw[j][3] * hi_bf(xv[1]); }
#pragma unroll
                for (int j = 0; j < 4; ++j) a[j] = siluf_(a[j]);
                *(f32x4*)(dst + (r0 + i) * 132 + col) = a; } }
        }
        if (tid < 64) {
            beta[tid] = sigmoidf_(nbb);
            float g = alh * softplusf_(naa + dth);
#pragma unroll
            for (int o = 1; o < 64; o <<= 1) { const float t = __shfl_up(g, o, 64); if (lane >= o) g += t; }
            gc[tid] = g; eg[tid] = __expf(g);
        }
        if (task + (int)gridDim.x < 2048) GP_LOAD(task + gridDim.x);
        LDS_BARRIER();
        for (int rr = wid; rr < 128; rr += 8) {
            float* arr = rr < 64 ? qs : ks; const int r = rr & 63; const float x0 = arr[r * 132 + lane], x1 = arr[r * 132 + 64 + lane];
            const float ss = wave_sum(x0 * x0 + x1 * x1); const float sc = rsqrtf(ss + 1e-6f) * (rr < 64 ? 0.08838834764831845f : 1.f);
            arr[r * 132 + lane] = x0 * sc; arr[r * 132 + 64 + lane] = x1 * sc;
        }
        LDS_BARRIER();
        for (int jj = 0; jj < 4; ++jj) {
            const int job = wid * 4 + jj, mat = job >> 4, tile = job & 15, ti = tile >> 2, tj = tile & 3;
            const float* Am = mat ? qs : ks;
            f32x4 acc = {0.f, 0.f, 0.f, 0.f};
            if (tj <= ti) {
#pragma unroll
                for (int kk = 0; kk < 4; ++kk) {
                    const float* ap = Am + (ti * 16 + (lane & 15)) * 132 + kk * 32 + (lane >> 4) * 8; const float* bp = ks + (tj * 16 + (lane & 15)) * 132 + kk * 32 + (lane >> 4) * 8;
                    const bf16x8 af = pack8v(*(const f32x4*)ap, *(const f32x4*)(ap + 4)), bf = pack8v(*(const f32x4*)bp, *(const f32x4*)(bp + 4));
                    acc = MFMA16(af, bf, acc);
                }
            }
            const int s = tj * 16 + (lane & 15);
#pragma unroll
            for (int j = 0; j < 4; ++j) { const int cc = ti * 16 + (lane >> 4) * 4 + j;
                if (mat == 0) { Ls[s * 68 + cc] = (cc > s) ? acc[j] * __expf(gc[cc] - gc[s]) * beta[cc] : 0.f; }
                else { QK[(size_t)task * 4096 + ((((cc >> 4) * 2 + (s >> 5)) * 64 + ((s >> 3) & 3) * 16 + (cc & 15)) << 3) + (s & 7)] = f2bf((cc >= s) ? acc[j] * __expf(gc[cc] - gc[s]) : 0.f); } }
        }
        LDS_BARRIER();
        {
#pragma unroll
            for (int i = 0; i < 2; ++i) { const int v = tid + 512 * i, cr = v >> 4, d8 = (v & 15) * 8; const float e = eg[cr]; float o[8];
#pragma unroll
                for (int j = 0; j < 8; ++j) o[j] = qs[cr * 132 + d8 + j] * e;
                *(bf16x8*)(QD + (size_t)task * 8192 + ((((cr >> 4) * 4 + (d8 >> 5)) * 64 + ((d8 >> 3) & 3) * 16 + (cr & 15)) << 3)) = pack8(o); }
            const float glast = gc[63];
#pragma unroll
            for (int i = 0; i < 2; ++i) { const int v = tid + 512 * i, dd = v >> 3, c8 = (v & 7) * 8; float o[8];
#pragma unroll
                for (int j = 0; j < 8; ++j) o[j] = ks[(c8 + j) * 132 + dd] * __expf(glast - gc[c8 + j]);
                *(bf16x8*)(KDT + (size_t)task * 8192 + ((((dd >> 4) * 2 + (c8 >> 5)) * 64 + ((c8 >> 3) & 3) * 16 + (dd & 15)) << 3)) = pack8(o); }
            if (tid == 0) GL[task] = eg[63];
        }
        LDS_BARRIER();
        if (tid < 256) {
            const int col = tid; const bool isu = col < 128; float* src = isu ? vs : ks; const int cc = isu ? col : col - 128;
#pragma unroll 1
            for (int rb = 0; rb < 4; ++rb) {
                float a[16];
#pragma unroll
                for (int i = 0; i < 16; ++i) { const int ci = rb * 16 + i; a[i] = src[ci * 132 + cc] * beta[ci] * (isu ? 1.f : eg[ci]); }
#pragma unroll 1
                for (int sx = 0; sx < rb * 16; ++sx) { const float sv = src[sx * 132 + cc];
#pragma unroll
                    for (int i4 = 0; i4 < 4; ++i4) { const f32x4 l = *(const f32x4*)(Ls + sx * 68 + rb * 16 + i4 * 4);
                        a[i4 * 4] -= l[0] * sv; a[i4 * 4 + 1] -= l[1] * sv; a[i4 * 4 + 2] -= l[2] * sv; a[i4 * 4 + 3] -= l[3] * sv; } }
#pragma unroll
                for (int i2 = 0; i2 < 16; ++i2) { const float sv = a[i2]; const int ci = rb * 16 + i2;
                    src[ci * 132 + cc] = sv;
                    if (isu) U[((size_t)task * 64 + ci) * 128 + cc] = sv; else Wb[(size_t)task * 8192 + ((((ci >> 4) * 4 + (cc >> 5)) * 64 + ((cc >> 3) & 3) * 16 + (ci & 15)) << 3) + (cc & 7)] = f2bf(sv);
#pragma unroll
                    for (int i4 = 0; i4 < 4; ++i4) { if (i4 * 4 + 3 > i2) { const f32x4 l = *(const f32x4*)(Ls + ci * 68 + rb * 16 + i4 * 4);
#pragma unroll
                        for (int j = 0; j < 4; ++j) if (i4 * 4 + j > i2) a[i4 * 4 + j] -= l[j] * sv; } } }
            }
        }
    }
}

#undef GP_LOAD
struct GdnOps { bf16x8 Aw[4], Aq[4], Aqk[2], Akd[2][2]; float u4[4]; float gl; };
__device__ __forceinline__ void ph_gdn_scan(unsigned char* shm, const Params* lp_) {
    const int tid = otid(), wid = tid >> 6, lane = tid & 63, grp = wid >> 2, mw = wid & 3, l15 = lane & 15, lq = lane >> 4;
    bf16_t* SBT = (bf16_t*)shm + grp * (16 * 136 + 16 * 72); bf16_t* VBT = SBT + 16 * 136;
    const int xw_ = blockIdx.x & 7, xi_ = blockIdx.x >> 3; const int ch = (xw_ * 4 + (xi_ >> 2)) * 8 + (xi_ & 3) * 2 + grp; const int sl = ch & 7, h = (ch >> 3) & 7, b = ch >> 6;
    const float* U = (const float*)(rflp(lp_->ws) + OFF_Y); const bf16_t* Wb = (const bf16_t*)(rflp(lp_->ws) + G_WB); const bf16_t* QD = (const bf16_t*)(rflp(lp_->ws) + G_QD); const bf16_t* QK = (const bf16_t*)(rflp(lp_->ws) + G_QK); const bf16_t* KDT = (const bf16_t*)(rflp(lp_->ws) + G_KDT); const float* GL = (const float*)(rflp(lp_->ws) + G_GL);
    float* O = (float*)(rflp(lp_->ws) + OFF_H);
    f32x4 S0 = {0.f, 0.f, 0.f, 0.f}, S1 = {0.f, 0.f, 0.f, 0.f};
#define GDN_LOAD(R, nn) do { const size_t task_ = ((size_t)b * 64 + (nn)) * 8 + h; \
        _Pragma("unroll") for (int k = 0; k < 4; ++k) { R.Aw[k] = *(const bf16x8*)(Wb + task_ * 8192 + (((mw * 4 + k) * 64 + lane) << 3)); R.Aq[k] = *(const bf16x8*)(QD + task_ * 8192 + (((mw * 4 + k) * 64 + lane) << 3)); } \
        _Pragma("unroll") for (int k = 0; k < 2; ++k) R.Aqk[k] = *(const bf16x8*)(QK + task_ * 4096 + (((mw * 2 + k) * 64 + lane) << 3)); \
        _Pragma("unroll") for (int i = 0; i < 2; ++i) _Pragma("unroll") for (int k = 0; k < 2; ++k) R.Akd[i][k] = *(const bf16x8*)(KDT + task_ * 8192 + ((((2 * mw + i) * 2 + k) * 64 + lane) << 3)); \
        _Pragma("unroll") for (int j = 0; j < 4; ++j) R.u4[j] = U[(task_ * 64 + 16 * mw + lq * 4 + j) * 128 + sl * 16 + l15]; \
        R.gl = GL[task_]; } while (0)
#define GDN_STEP(R, nn) do { \
        { const u32x2 w0 = {cvt_pk_bf16(S0[0], S0[1]), cvt_pk_bf16(S0[2], S0[3])}, w1 = {cvt_pk_bf16(S1[0], S1[1]), cvt_pk_bf16(S1[2], S1[3])}; \
          *(u32x2*)(SBT + l15 * 136 + 32 * mw + lq * 4) = w0; *(u32x2*)(SBT + l15 * 136 + 32 * mw + 16 + lq * 4) = w1; } \
        LDS_BARRIER(); \
        f32x4 P = {0.f, 0.f, 0.f, 0.f}, O1 = {0.f, 0.f, 0.f, 0.f}; \
        _Pragma("unroll") for (int k = 0; k < 4; ++k) { const bf16x8 sb = *(const bf16x8*)(SBT + l15 * 136 + k * 32 + lq * 8); P = MFMA16(R.Aw[k], sb, P); O1 = MFMA16(R.Aq[k], sb, O1); } \
        const f32x4 vn = {R.u4[0] - P[0], R.u4[1] - P[1], R.u4[2] - P[2], R.u4[3] - P[3]}; \
        { const u32x2 w = {cvt_pk_bf16(vn[0], vn[1]), cvt_pk_bf16(vn[2], vn[3])}; *(u32x2*)(VBT + l15 * 72 + 16 * mw + lq * 4) = w; } \
        LDS_BARRIER(); \
        bf16x8 Vb[2]; \
        _Pragma("unroll") for (int k = 0; k < 2; ++k) Vb[k] = *(const bf16x8*)(VBT + l15 * 72 + k * 32 + lq * 8); \
        _Pragma("unroll") for (int k = 0; k < 2; ++k) O1 = MFMA16(R.Aqk[k], Vb[k], O1); \
        _Pragma("unroll") for (int j = 0; j < 4; ++j) O[((size_t)b * T + (nn) * 64 + 16 * mw + lq * 4 + j) * 1024 + h * 128 + sl * 16 + l15] = O1[j]; \
        S0 *= R.gl; S1 *= R.gl; \
        _Pragma("unroll") for (int k = 0; k < 2; ++k) { S0 = MFMA16(R.Akd[0][k], Vb[k], S0); S1 = MFMA16(R.Akd[1][k], Vb[k], S1); } } while (0)
    GdnOps RA, RB;
    GDN_LOAD(RA, 0); GDN_LOAD(RB, 1);
    for (int n = 0; n < 64; n += 2) {
        GDN_STEP(RA, n);
        if (n + 2 < 64) GDN_LOAD(RA, n + 2);
        GDN_STEP(RB, n + 1);
        if (n + 3 < 64) GDN_LOAD(RB, n + 3);
    }
#undef GDN_LOAD
#undef GDN_STEP
}

__device__ __forceinline__ void ph_gdn_gate(const Params* lp_) {
    const int tid_ = otid(); const int wid = tid_ >> 6, lane = tid_ & 63; const int hh = lane >> 3, sub = lane & 7;
    const float* O = (const float*)(rflp(lp_->ws) + OFF_H); const bf16_t* PROJ = (const bf16_t*)(rflp(lp_->ws) + G_PROJ); bf16_t* OG = (bf16_t*)(rflp(lp_->ws) + OFF_XN); const float* nw = rflp(lp_->in[8]);
    f32x4 nwv[4];
#pragma unroll
    for (int i = 0; i < 4; ++i) nwv[i] = *(const f32x4*)(nw + sub * 16 + i * 4);
    const int col = hh * 128 + sub * 16;
    f32x4 no[4]; u32x4 nz0, nz1; int row = blockIdx.x * 8 + wid;
#define GG_LOAD(rr_) do { _Pragma("unroll") for (int i = 0; i < 4; ++i) no[i] = *(const f32x4*)(O + (size_t)(rr_) * 1024 + col + i * 4); \
        nz0 = *(const u32x4*)(PROJ + (size_t)(rr_) * 4352 + 3072 + col); nz1 = *(const u32x4*)(PROJ + (size_t)(rr_) * 4352 + 3072 + col + 8); } while (0)
    GG_LOAD(row);
    for (; row < M; row += gridDim.x * 8) {
        f32x4 o[4]; float ss = 0.f; const u32x4 z0 = nz0, z1 = nz1;
#pragma unroll
        for (int i = 0; i < 4; ++i) { o[i] = no[i]; ss += o[i][0] * o[i][0] + o[i][1] * o[i][1] + o[i][2] * o[i][2] + o[i][3] * o[i][3]; }
        if (row + (int)gridDim.x * 8 < M) GG_LOAD(row + gridDim.x * 8);
        ss += __shfl_xor(ss, 1, 64); ss += __shfl_xor(ss, 2, 64); ss += __shfl_xor(ss, 4, 64);
        const float inv = rsqrtf(ss * (1.f / 128.f) + 1e-6f);
        float v[16];
#pragma unroll
        for (int i = 0; i < 4; ++i) { const f32x4 w = nwv[i];
#pragma unroll
            for (int j = 0; j < 4; ++j) v[i * 4 + j] = o[i][j] * inv * w[j]; }
#pragma unroll
        for (int i = 0; i < 4; ++i) { v[2 * i] *= siluf_(lo_bf(z0[i])); v[2 * i + 1] *= siluf_(hi_bf(z0[i])); v[8 + 2 * i] *= siluf_(lo_bf(z1[i])); v[8 + 2 * i + 1] *= siluf_(hi_bf(z1[i])); }
        *(bf16x8*)(OG + (size_t)row * 1024 + col) = pack8(v); *(bf16x8*)(OG + (size_t)row * 1024 + col + 8) = pack8(v + 8);
    }
#undef GG_LOAD
}

__device__ __forceinline__ void ph_rwkv_mix(const Params* lp_) {
    const bf16_t* XN = (const bf16_t*)(rflp(lp_->ws) + OFF_XN); bf16_t* XM = (bf16_t*)(rflp(lp_->ws) + R_XM); const float* mu = rflp(lp_->in[10]);
    const int v0_ = blockIdx.x * 512 + otid(); const int cfix = (v0_ & 127) * 8;
    f32x4 muv[6][2];
#pragma unroll
    for (int i = 0; i < 6; ++i) { muv[i][0] = *(const f32x4*)(mu + i * 1024 + cfix); muv[i][1] = *(const f32x4*)(mu + i * 1024 + cfix + 4); }
    const int c = cfix; u32x4 nxc, nxp; int v = v0_;
#define MIX_LOAD(vv_) do { const int r_ = (vv_) >> 7; const int rp_ = (r_ & (T - 1)) > 0 ? r_ - 1 : r_; nxc = *(const u32x4*)(XN + (size_t)r_ * 1024 + c); nxp = *(const u32x4*)(XN + (size_t)rp_ * 1024 + c); } while (0)
    MIX_LOAD(v);
    for (; v < M * 128; v += gridDim.x * 512) {
        const int row = v >> 7; const int t = row & (T - 1);
        const u32x4 xc = nxc; u32x4 xp = nxp; if (t == 0) xp = (u32x4){0u, 0u, 0u, 0u};
        if (v + (int)gridDim.x * 512 < M * 128) MIX_LOAD(v + gridDim.x * 512);
        float x[8], dx[8];
#pragma unroll
        for (int i = 0; i < 4; ++i) { x[2 * i] = lo_bf(xc[i]); x[2 * i + 1] = hi_bf(xc[i]); dx[2 * i] = lo_bf(xp[i]) - x[2 * i]; dx[2 * i + 1] = hi_bf(xp[i]) - x[2 * i + 1]; }
#pragma unroll
        for (int i = 0; i < 6; ++i) { const f32x4 m0 = muv[i][0], m1 = muv[i][1]; float o[8];
#pragma unroll
            for (int j = 0; j < 4; ++j) { o[j] = x[j] + dx[j] * m0[j]; o[4 + j] = x[4 + j] + dx[4 + j] * m1[j]; }
            *(bf16x8*)(XM + (size_t)row * 6144 + i * 1024 + c) = pack8(o); }
    }
#undef MIX_LOAD
}

constexpr int WT2_TOTAL = 4 * (2816 + 1408) + 2688 + 1024 + 1024 + 4 * 64 + 512;
struct WTile { const float* sp; bf16_t* dp; int ok; };
__device__ __forceinline__ WTile wtile_decode(const Params* lp_, int ti, int lane) {
    unsigned char* ws = rflp(lp_->ws);
    const float* src; int K, Ns, Nd, ldd, half = 0; bf16_t* dst; int j2 = 0, t = ti;
    for (; j2 < 16; ++j2) {
        const int cnt = j2 < 8 ? ((j2 & 1) ? 1408 : 2816) : (j2 == 8 ? 2688 : (j2 == 9 ? 1024 : (j2 == 10 ? 1024 : (j2 < 15 ? 64 : 512))));
        if (t < cnt) break; t -= cnt;
    }
    if (j2 < 8) { const int i = 4 + (j2 >> 1);
        if ((j2 & 1) == 0) { src = rflp(lp_->in[2]) + (size_t)i * 1024 * 5632; K = 1024; Ns = 5632; Nd = 5632; dst = (bf16_t*)(ws + OFF_WF_IN + i * SZ_WF_IN1); ldd = 1024; half = 2816; }
        else { src = rflp(lp_->in[3]) + (size_t)i * 2816 * 1024; K = 2816; Ns = 1024; Nd = 1024; dst = (bf16_t*)(ws + OFF_WF_OUT + i * SZ_WF_OUT1); ldd = 2816; } }
    else if (j2 == 8) { src = rflp(lp_->in[26]); K = 1024; Ns = 5152; Nd = 5376; dst = (bf16_t*)(ws + OFF_W_SSD_IN); ldd = 1024; }
    else if (j2 == 9) { src = rflp(lp_->in[33]); K = 2048; Ns = 1024; Nd = 1024; dst = (bf16_t*)(ws + OFF_W_SSD_OUT); ldd = 2048; }
    else if (j2 == 10) { src = rflp(lp_->in[34]); K = 1024; Ns = 2048; Nd = 2048; dst = (bf16_t*)(ws + OFF_W_LRU_IN); ldd = 1024; }
    else if (j2 < 15) { src = rflp(lp_->in[37]) + (size_t)(j2 - 11) * 256 * 512; K = 256; Ns = 512; Nd = 512; dst = (bf16_t*)(ws + OFF_W_LRU_G) + (size_t)(j2 - 11) * 512 * 256; ldd = 256; half = 256; }
    else { src = rflp(lp_->in[40]); K = 1024; Ns = 1024; Nd = 1024; dst = (bf16_t*)(ws + OFF_W_LRU_OUT); ldd = 1024; }
    (void)K;
    const int tn = Nd / 64, kt = t / tn, ntile = t % tn, k0 = kt * 32, gn = ntile * 64 + lane;
    int drow = gn;
    if (half) drow = gn < half ? (gn / 128) * 256 + (gn % 128) : ((gn - half) / 128) * 256 + 128 + ((gn - half) % 128);
    WTile w; w.ok = gn < Ns; w.sp = src + (size_t)k0 * Ns + (w.ok ? gn : 0); w.dp = dst + (size_t)drow * ldd + k0;
    w.ok |= (Ns << 1);
    return w;
}

constexpr int RW_TC = 32, RW_STRIDE = 392;
__device__ __forceinline__ void ph_rwkv_scan(unsigned char* shm, const Params* lp_) {
    float* buf = (float*)shm;
    const int tid = otid(), wid = tid >> 6, lane = tid & 63;
    const float* Rr = (const float*)(rflp(lp_->ws) + OFF_Y); const float* Kk = (const float*)(rflp(lp_->ws) + R_K); const float* Vv = (const float*)(rflp(lp_->ws) + R_V);
    const float* Wd = (const float*)(rflp(lp_->ws) + R_XM); const float* Aa = Wd + MS * 1024;
    float* YS = (float*)(rflp(lp_->ws) + OFF_H);
    const float* k_k = rflp(lp_->in[20]); const float* k_a = rflp(lp_->in[21]); const float* r_k = rflp(lp_->in[22]); float* RKB = (float*)(rflp(lp_->ws) + R_LOR);
    for (int item0 = blockIdx.x; item0 < 256; item0 += gridDim.x) {
        const int item = ((item0 & 7) * 8 + (item0 >> 5)) * 4 + ((item0 >> 3) & 3);
        const int q = item & 3, h = (item >> 2) & 15, b = item >> 6;
        __syncthreads();
        if (wid >= 4) {
            const int lw = wid - 4, rr = lane >> 4, seg = lane & 15, c = h * 64 + seg * 4;
            const f32x4 kkc = *(const f32x4*)(k_k + c), kac = *(const f32x4*)(k_a + c), rkc = *(const f32x4*)(r_k + c);
            f32x4 r[2], k[2], v[2], w[2], a[2];
#pragma unroll
            for (int ps = 0; ps < 2; ++ps) { const size_t idx = ((size_t)b * T + lw * 8 + ps * 4 + rr) * 1024 + c;
                r[ps] = *(const f32x4*)(Rr + idx); k[ps] = *(const f32x4*)(Kk + idx); v[ps] = *(const f32x4*)(Vv + idx); w[ps] = *(const f32x4*)(Wd + idx); a[ps] = *(const f32x4*)(Aa + idx); }
            float cv[32]; bf16_t* cdp = nullptr; int cok = 0;
            const int gw = blockIdx.x * 4 + lw;
            for (int ci = -1; ci < T / RW_TC - 1; ++ci) {
                if ((ci & 3) == 0) {
                    if (cdp != nullptr) {
                        if (!(cok & 1)) {
#pragma unroll
                            for (int j = 0; j < 32; ++j) cv[j] = 0.f; }
#pragma unroll
                        for (int j = 0; j < 4; ++j) *(bf16x8*)(cdp + j * 8) = pack8(cv + j * 8);
                        cdp = nullptr;
                    }
                    const int ti = gw + 1024 * (ci >> 2);
                    if (ti < WT2_TOTAL) {
                        const WTile wt = wtile_decode(lp_, ti, lane); cdp = wt.dp; cok = wt.ok; const int nsrc = wt.ok >> 1;
#pragma unroll
                        for (int j = 0; j < 32; ++j) cv[j] = wt.sp[(size_t)j * nsrc];
                    }
                }
                float* bb = buf + ((ci + 1) & 1) * (RW_TC * RW_STRIDE);
#pragma unroll
                for (int ps = 0; ps < 2; ++ps) {
                    const f32x4 kkr = k[ps] * kkc; const float n2 = dpp_sum16(kkr[0] * kkr[0] + kkr[1] * kkr[1] + kkr[2] * kkr[2] + kkr[3] * kkr[3]);
                    const f32x4 kk = kkr * rsqrtf(n2 + 1e-6f); const f32x4 kp = k[ps] * (1.f + (a[ps] - 1.f) * kac); const f32x4 bt = kk * a[ps];
                    const f32x4 t1 = bt * r[ps], t2 = kp * r[ps];
                    const float br = dpp_sum16(t1[0] + t1[1] + t1[2] + t1[3]), kr = dpp_sum16(t2[0] + t2[1] + t2[2] + t2[3]);
                    const f32x4 t3 = t2 * rkc; const float rkv = dpp_sum16(t3[0] + t3[1] + t3[2] + t3[3]);
                    if (q == 0 && seg == 0) RKB[((size_t)b * T + (ci + 1) * RW_TC + lw * 8 + ps * 4 + rr) * 16 + h] = rkv;
                    float* o = bb + (lw * 8 + ps * 4 + rr) * RW_STRIDE;
                    *(f32x4*)(o + seg * 4) = w[ps]; *(f32x4*)(o + 64 + seg * 4) = kp; *(f32x4*)(o + 128 + seg * 4) = -kk; *(f32x4*)(o + 192 + seg * 4) = bt; *(f32x4*)(o + 256 + seg * 4) = w[ps] * r[ps]; *(f32x4*)(o + 320 + seg * 4) = v[ps];
                    if (seg == 0) { o[384] = br; o[385] = kr; }
                }
                if (ci + 2 < T / RW_TC) {
#pragma unroll
                    for (int ps = 0; ps < 2; ++ps) { const size_t idx = ((size_t)b * T + (ci + 2) * RW_TC + lw * 8 + ps * 4 + rr) * 1024 + c;
                        r[ps] = *(const f32x4*)(Rr + idx); k[ps] = *(const f32x4*)(Kk + idx); v[ps] = *(const f32x4*)(Vv + idx); w[ps] = *(const f32x4*)(Wd + idx); a[ps] = *(const f32x4*)(Aa + idx); }
                }
                LDS_BARRIER();
            }
            if (cdp != nullptr) {
                if (!(cok & 1)) {
#pragma unroll
                    for (int j = 0; j < 32; ++j) cv[j] = 0.f; }
#pragma unroll
                for (int j = 0; j < 4; ++j) *(bf16x8*)(cdp + j * 8) = pack8(cv + j * 8);
            }
            LDS_BARRIER();
        } else {
            const int rr = lane >> 4, seg = lane & 15, vrow = 16 * q + 4 * wid + rr;
            f32x4 S = {0.f, 0.f, 0.f, 0.f};
            LDS_BARRIER();
            for (int ci = 0; ci < T / RW_TC; ++ci) {
                const float* bb = buf + (ci & 1) * (RW_TC * RW_STRIDE);
                f32x4 nw4, nk4, na4, nb4, nwr4; float nvv, nbr, nkr;
#define RW_LOADV(ss) do { const float* o_ = bb + (ss) * RW_STRIDE; nw4 = *(const f32x4*)(o_ + seg * 4); nk4 = *(const f32x4*)(o_ + 64 + seg * 4); na4 = *(const f32x4*)(o_ + 128 + seg * 4); \
                    nb4 = *(const f32x4*)(o_ + 192 + seg * 4); nwr4 = *(const f32x4*)(o_ + 256 + seg * 4); nvv = o_[320 + vrow]; nbr = o_[384]; nkr = o_[385]; } while (0)
                RW_LOADV(0);
#pragma unroll
                for (int s16 = 0; s16 < RW_TC / 16; ++s16) {
                    float ykeep = 0.f;
#pragma unroll
                    for (int s1 = 0; s1 < 16; ++s1) {
                        const f32x4 w4 = nw4, k4 = nk4, a4 = na4, b4 = nb4, wr4 = nwr4; const float vv = nvv, br = nbr, kr = nkr;
                        if (s16 * 16 + s1 + 1 < RW_TC) RW_LOADV(s16 * 16 + s1 + 1);
                        asm volatile("" ::: "memory");
                        const float p1 = (S[0] * a4[0] + S[1] * a4[1]) + (S[2] * a4[2] + S[3] * a4[3]);
                        const float p2 = (S[0] * wr4[0] + S[1] * wr4[1]) + (S[2] * wr4[2] + S[3] * wr4[3]);
                        const float sa = dpp_sum16(p1), y0 = dpp_sum16(p2);
                        const float y = y0 + sa * br + vv * kr;
                        S = S * w4 + sa * b4 + vv * k4;
                        ykeep = (seg == s1) ? y : ykeep;
                    }
                    YS[((size_t)b * T + ci * RW_TC + s16 * 16 + seg) * 1024 + h * 64 + vrow] = ykeep;
                }
#undef RW_LOADV
                LDS_BARRIER();
            }
        }
    }
}

__device__ __forceinline__ void ph_rwkv_post(const Params* lp_) {
    const int tid_ = otid(); const int wid = tid_ >> 6, lane = tid_ & 63;
    const float* YS = (const float*)(rflp(lp_->ws) + OFF_H); const float* Vv = (const float*)(rflp(lp_->ws) + R_V); const float* RKB = (const float*)(rflp(lp_->ws) + R_LOR);
    const float* Gg = (const float*)(rflp(lp_->ws) + R_XM) + 2 * MS * 1024; bf16_t* YG = (bf16_t*)(rflp(lp_->ws) + OFF_XN);
    const float* ln_w = rflp(lp_->in[23]); const float* ln_b = rflp(lp_->in[24]);
    f32x4 lwv[4], lbv[4];
#pragma unroll
    for (int i = 0; i < 4; ++i) { lwv[i] = *(const f32x4*)(ln_w + lane * 16 + i * 4); lbv[i] = *(const f32x4*)(ln_b + lane * 16 + i * 4); }
    const int c0 = lane * 16; f32x4 ny[4], nv[4], ng[4]; float nrk; int row = blockIdx.x * 8 + wid;
#define RP_LOAD(rr_) do { _Pragma("unroll") for (int i = 0; i < 4; ++i) { const size_t idx_ = (size_t)(rr_) * 1024 + c0 + i * 4; ny[i] = *(const f32x4*)(YS + idx_); nv[i] = *(const f32x4*)(Vv + idx_); ng[i] = *(const f32x4*)(Gg + idx_); } \
        nrk = RKB[(size_t)(rr_) * 16 + (lane >> 2)]; } while (0)
    RP_LOAD(row);
    for (; row < M; row += gridDim.x * 8) {
        float y[16], out[16]; float s1 = 0.f; f32x4 vv[4], gg[4]; const float rk = nrk;
#pragma unroll
        for (int i = 0; i < 4; ++i) { vv[i] = nv[i]; gg[i] = ng[i];
#pragma unroll
            for (int j = 0; j < 4; ++j) { y[i * 4 + j] = ny[i][j]; s1 += ny[i][j]; } }
        if (row + (int)gridDim.x * 8 < M) RP_LOAD(row + gridDim.x * 8);
        s1 += __shfl_xor(s1, 1, 64); s1 += __shfl_xor(s1, 2, 64); const float mean = s1 * (1.f / 64.f);
        float s2 = 0.f;
#pragma unroll
        for (int i = 0; i < 16; ++i) { const float d = y[i] - mean; s2 += d * d; }
        s2 += __shfl_xor(s2, 1, 64); s2 += __shfl_xor(s2, 2, 64); const float inv = rsqrtf(s2 * (1.f / 64.f) + 64e-5f);
#pragma unroll
        for (int i = 0; i < 4; ++i) { const f32x4 lw = lwv[i], lb = lbv[i];
#pragma unroll
            for (int j = 0; j < 4; ++j) out[i * 4 + j] = ((y[i * 4 + j] - mean) * inv * lw[j] + lb[j] + rk * vv[i][j]) * gg[i][j]; }
        *(bf16x8*)(YG + (size_t)row * 1024 + c0) = pack8(out); *(bf16x8*)(YG + (size_t)row * 1024 + c0 + 8) = pack8(out + 8);
    }
#undef RP_LOAD
}

__device__ __forceinline__ void ph_ssd_prep(unsigned char* shm, const Params* lp_) {
    bf16_t* tl = (bf16_t*)shm; float* dtl = (float*)(shm + 64 * 136 * 2); float* carry = dtl + 128;
    const int tid = otid(), lane = tid & 63;
    const bf16_t* PROJ = (const bf16_t*)(rflp(lp_->ws) + S_PROJ); const float* DT = (const float*)(rflp(lp_->ws) + S_DT);
    bf16_t* BCN = (bf16_t*)(rflp(lp_->ws) + S_BCN); bf16_t* XDTT = (bf16_t*)(rflp(lp_->ws) + S_XDTT); bf16_t* BMT = (bf16_t*)(rflp(lp_->ws) + S_BMT); float* DTV = (float*)(rflp(lp_->ws) + S_DTV); float* ACS = (float*)(rflp(lp_->ws) + S_ACS);
    const float* convw = rflp(lp_->in[27]); const float* convb = rflp(lp_->in[28]); const float* dtb = rflp(lp_->in[29]); const float* a_log = rflp(lp_->in[30]);
    const int j = blockIdx.x % 48, gi = blockIdx.x / 48, gs = (int)(gridDim.x / 48) + ((int)(gridDim.x % 48) > j ? 1 : 0);
    const int l = tid >> 2, cb = (tid & 3) * 16; const int ch = j * 64 + cb;
    f32x4 wv[4][4], bv4[4];
#pragma unroll
    for (int jj = 0; jj < 4; ++jj)
#pragma unroll
        for (int i = 0; i < 4; ++i) wv[jj][i] = *(const f32x4*)(convw + jj * 3072 + ch + i * 4);
#pragma unroll
    for (int i = 0; i < 4; ++i) bv4[i] = *(const f32x4*)(convb + ch + i * 4);
    const float dtbj = j < 32 ? dtb[j] : 0.f, aj = j < 32 ? -__expf(a_log[j]) : 0.f;
    u32x4 xr[4][2]; float ndt = 0.f;
#define SP_LOAD(bc_) do { const int c_ = (bc_) & 31, b_ = (bc_) >> 5; const int tl_ = c_ * 128 + l; \
        _Pragma("unroll") for (int jj = 0; jj < 4; ++jj) { const int tt = tl_ - 3 + jj; const int ttc = tt < 0 ? 0 : tt; const bf16_t* src = PROJ + ((size_t)b_ * T + ttc) * 5376 + 2048 + ch; \
            xr[jj][0] = *(const u32x4*)src; xr[jj][1] = *(const u32x4*)(src + 8); } \
        if (j < 32 && tid < 128) ndt = DT[((size_t)b_ * T + c_ * 128 + tid) * 32 + j]; } while (0)
    if (gi < 128) SP_LOAD(gi);
    for (int bc = gi; bc < 128; bc += gs) {
        const int c = bc & 31, b = bc >> 5; const size_t row0 = (size_t)b * T + c * 128; const int tloc = c * 128 + l;
        LDS_BARRIER();
        if (j < 32 && tid < 128) {
            const float dt = softplusf_(ndt + dtbj); float da = dt * aj;
#pragma unroll
            for (int o = 1; o < 64; o <<= 1) { const float t = __shfl_up(da, o, 64); if (lane >= o) da += t; }
            dtl[tid] = dt; carry[1 + tid] = da; if (tid == 63) carry[0] = da;
        }
        LDS_BARRIER();
        if (j < 32 && tid < 128) {
            ACS[((size_t)bc * 32 + j) * 128 + tid] = carry[1 + tid] + (tid >= 64 ? carry[0] : 0.f);
            DTV[((size_t)bc * 32 + j) * 128 + tid] = dtl[tid];
        }
        float val[16];
#pragma unroll
        for (int i = 0; i < 4; ++i) { val[i * 4] = bv4[i][0]; val[i * 4 + 1] = bv4[i][1]; val[i * 4 + 2] = bv4[i][2]; val[i * 4 + 3] = bv4[i][3]; }
#pragma unroll
        for (int jj = 0; jj < 4; ++jj) { const float msk = (tloc - 3 + jj) < 0 ? 0.f : 1.f;
            const unsigned xw[8] = {xr[jj][0][0], xr[jj][0][1], xr[jj][0][2], xr[jj][0][3], xr[jj][1][0], xr[jj][1][1], xr[jj][1][2], xr[jj][1][3]};
#pragma unroll
            for (int i = 0; i < 4; ++i) { const f32x4 w = wv[jj][i] * msk; const unsigned xa = xw[2 * i], xb = xw[2 * i + 1];
                val[i * 4] += w[0] * lo_bf(xa); val[i * 4 + 1] += w[1] * hi_bf(xa); val[i * 4 + 2] += w[2] * lo_bf(xb); val[i * 4 + 3] += w[3] * hi_bf(xb); } }
        if (bc + gs < 128) SP_LOAD(bc + gs);
#pragma unroll
        for (int i = 0; i < 16; ++i) val[i] = siluf_(val[i]);
        if (j >= 32) { bf16_t* dst = BCN + (row0 + l) * 1024 + (j - 32) * 64 + cb; *(bf16x8*)dst = pack8(val); *(bf16x8*)(dst + 8) = pack8(val + 8); }
        if (j < 40) {
            const float sc = j < 32 ? dtl[l] : 1.f;
#pragma unroll
            for (int i = 0; i < 16; ++i) tl[(cb + i) * 136 + l] = f2bf(val[i] * sc);
            LDS_BARRIER();
            bf16_t* dbase = j < 32 ? XDTT + ((size_t)bc * 32 + j) * 64 * 128 : BMT + (((size_t)bc * 4 + ((j - 32) >> 1)) * 128 + ((j - 32) & 1) * 64) * 128;
#pragma unroll
            for (int i = 0; i < 2; ++i) { const int v = tid + 512 * i, col = v >> 4, l8 = (v & 15) * 8; *(u32x4*)(dbase + (size_t)col * 128 + l8) = *(const u32x4*)(tl + col * 136 + l8); }
        }
    }
#undef SP_LOAD
}

__device__ __forceinline__ void ph_ssd_states(unsigned char* shm, const Params* lp_) {
    float* ds = (float*)shm; bf16_t* BmL = (bf16_t*)(shm + 1024); bf16_t* XdL = BmL + 128 * 136;
    const int tid = otid(), wid = tid >> 6, lane = tid & 63, l15 = lane & 15, lq = lane >> 4;
    const bf16_t* XDTT = (const bf16_t*)(rflp(lp_->ws) + S_XDTT); const bf16_t* BMT = (const bf16_t*)(rflp(lp_->ws) + S_BMT); const float* ACS = (const float*)(rflp(lp_->ws) + S_ACS); bf16_t* ST = (bf16_t*)(rflp(lp_->ws) + OFF_H);
    u32x4 gb[4], gx[2]; float dsv = 0.f;
#define ST_TASK(t0_) ((((((t0_) & 7) * 64 + ((((t0_) >> 8) * 32 + (((t0_) & 255) >> 3)) >> 3)) >> 2) * 32) + (((((t0_) & 7) * 64 + ((((t0_) >> 8) * 32 + (((t0_) & 255) >> 3)) >> 3)) & 3) * 8) + ((((t0_) >> 8) * 32 + (((t0_) & 255) >> 3)) & 7))
#define ST_LOAD(t0_) do { const int tk_ = ST_TASK(t0_); const int h_ = tk_ & 31, bc_ = tk_ >> 5, g_ = h_ >> 3; \
        _Pragma("unroll") for (int i = 0; i < 4; ++i) { const int v = tid + 512 * i; gb[i] = *(const u32x4*)(BMT + (((size_t)bc_ * 4 + g_) * 128 + (v >> 4)) * 128 + (v & 15) * 8); } \
        _Pragma("unroll") for (int i = 0; i < 2; ++i) { const int v = tid + 512 * i; gx[i] = *(const u32x4*)(XDTT + ((size_t)tk_ * 64 + (v >> 4)) * 128 + (v & 15) * 8); } \
        if (tid < 128) dsv = ACS[(size_t)tk_ * 128 + 127] - ACS[(size_t)tk_ * 128 + tid]; } while (0)
    ST_LOAD(blockIdx.x);
    for (int task0 = blockIdx.x; task0 < 4096; task0 += gridDim.x) {
        const int task = ST_TASK(task0);
        LDS_BARRIER();
#pragma unroll
        for (int i = 0; i < 4; ++i) { const int v = tid + 512 * i; *(u32x4*)(BmL + (v >> 4) * 136 + (v & 15) * 8) = gb[i]; }
#pragma unroll
        for (int i = 0; i < 2; ++i) { const int v = tid + 512 * i; *(u32x4*)(XdL + (v >> 4) * 136 + (v & 15) * 8) = gx[i]; }
        if (tid < 128) ds[tid] = __expf(dsv);
        LDS_BARRIER();
        if (task0 + (int)gridDim.x < 4096) ST_LOAD(task0 + gridDim.x);
        f32x4 acc[4];
#pragma unroll
        for (int i = 0; i < 4; ++i) acc[i] = (f32x4){0.f, 0.f, 0.f, 0.f};
#pragma unroll
        for (int k = 0; k < 4; ++k) {
            const u32x4 braw = *(const u32x4*)(BmL + (16 * wid + l15) * 136 + k * 32 + lq * 8);
            const f32x4 d0 = *(const f32x4*)(ds + k * 32 + lq * 8), d1 = *(const f32x4*)(ds + k * 32 + lq * 8 + 4);
            float bv[8] = {lo_bf(braw[0]) * d0[0], hi_bf(braw[0]) * d0[1], lo_bf(braw[1]) * d0[2], hi_bf(braw[1]) * d0[3], lo_bf(braw[2]) * d1[0], hi_bf(braw[2]) * d1[1], lo_bf(braw[3]) * d1[2], hi_bf(braw[3]) * d1[3]};
            const bf16x8 bf = pack8(bv);
#pragma unroll
            for (int pt = 0; pt < 4; ++pt) { const bf16x8 af = *(const bf16x8*)(XdL + (16 * pt + l15) * 136 + k * 32 + lq * 8); acc[pt] = MFMA16(af, bf, acc[pt]); }
        }
#pragma unroll
        for (int pt = 0; pt < 4; ++pt)
#pragma unroll
            for (int j = 0; j < 4; ++j) ST[((size_t)task * 64 + 16 * pt + lq * 4 + j) * 128 + 16 * wid + l15] = f2bf(acc[pt][j]);
    }
}

#undef ST_LOAD
#undef ST_TASK
__device__ __forceinline__ void ph_ssd_chunkscan(const Params* lp_) {
    const bf16_t* ST = (const bf16_t*)(rflp(lp_->ws) + OFF_H); bf16_t* PREV = (bf16_t*)(rflp(lp_->ws) + OFF_Y); const float* ACS = (const float*)(rflp(lp_->ws) + S_ACS);
    for (int v = blockIdx.x * 512 + otid(); v < 4 * 32 * 64 * 16; v += gridDim.x * 512) {
        const int n8 = (v & 15) * 8, pp = (v >> 4) & 63, h = (v >> 10) & 31, b = v >> 15;
        float hc[8];
#pragma unroll
        for (int i = 0; i < 8; ++i) hc[i] = 0.f;
        const size_t task0 = (size_t)b * 32 * 32 + h; float nacs = ACS[task0 * 128 + 127]; u32x4 ns = *(const u32x4*)(ST + (task0 * 64 + pp) * 128 + n8);
        for (int c = 0; c < 32; ++c) {
            const size_t task = ((size_t)b * 32 + c) * 32 + h; const size_t off = (task * 64 + pp) * 128 + n8;
            *(bf16x8*)(PREV + off) = pack8(hc);
            const float dec = __expf(nacs); const u32x4 s = ns;
            if (c + 1 < 32) { const size_t tn_ = task + 32; nacs = ACS[tn_ * 128 + 127]; ns = *(const u32x4*)(ST + (tn_ * 64 + pp) * 128 + n8); }
#pragma unroll
            for (int i = 0; i < 4; ++i) { hc[2 * i] = dec * hc[2 * i] + lo_bf(s[i]); hc[2 * i + 1] = dec * hc[2 * i + 1] + hi_bf(s[i]); }
        }
    }
}

__device__ __forceinline__ void ph_ssd_out(unsigned char* shm, const Params* lp_) {
    const int tid = otid(), wid = tid >> 6, lane = tid & 63, l15 = lane & 15, lq = lane >> 4;
    float* acs = (float*)shm; float* dtl = acs + 128; bf16_t* BmL = (bf16_t*)(shm + 1024); bf16_t* XdL = BmL + 128 * 136; bf16_t* PvL = XdL + 64 * 136; bf16_t* sc = PvL + 64 * 136 + wid * (16 * 136);
    const bf16_t* PROJ = (const bf16_t*)(rflp(lp_->ws) + S_PROJ); const bf16_t* BCN = (const bf16_t*)(rflp(lp_->ws) + S_BCN); const bf16_t* XDTT = (const bf16_t*)(rflp(lp_->ws) + S_XDTT);
    const bf16_t* PREV = (const bf16_t*)(rflp(lp_->ws) + OFF_Y); const float* DTV = (const float*)(rflp(lp_->ws) + S_DTV); const float* ACS = (const float*)(rflp(lp_->ws) + S_ACS); bf16_t* YS = (bf16_t*)(rflp(lp_->ws) + OFF_H);
    const float* dsk = rflp(lp_->in[31]);
    for (int task0 = blockIdx.x; task0 < 4096; task0 += gridDim.x) {
        const int slot_ = (task0 >> 8) * 32 + ((task0 & 255) >> 3); const int G_ = (task0 & 7) * 64 + (slot_ >> 3); const int task = (G_ >> 2) * 32 + (G_ & 3) * 8 + (slot_ & 7);
        const int h = task & 31, bc = task >> 5, g = h >> 3, c = bc & 31, b = bc >> 5; const size_t row0 = (size_t)b * T + c * 128;
        const int l0 = 16 * wid + lq * 4;
        u32x4 gb[4], gx[2], gp[2]; bf16x8 Cf[4]; bf16_t zz[4][4];
#pragma unroll
        for (int i = 0; i < 4; ++i) { const int v = tid + 512 * i; gb[i] = *(const u32x4*)(BCN + (row0 + (v >> 4)) * 1024 + g * 128 + (v & 15) * 8); }
#pragma unroll
        for (int i = 0; i < 2; ++i) { const int v = tid + 512 * i; gx[i] = *(const u32x4*)(XDTT + ((size_t)task * 64 + (v >> 4)) * 128 + (v & 15) * 8); gp[i] = *(const u32x4*)(PREV + ((size_t)task * 64 + (v >> 4)) * 128 + (v & 15) * 8); }
#pragma unroll
        for (int k = 0; k < 4; ++k) Cf[k] = *(const bf16x8*)(BCN + (row0 + 16 * wid + l15) * 1024 + 512 + g * 128 + k * 32 + lq * 8);
#pragma unroll
        for (int pt = 0; pt < 4; ++pt)
#pragma unroll
            for (int j = 0; j < 4; ++j) zz[pt][j] = PROJ[(row0 + l0 + j) * 5376 + h * 64 + 16 * pt + l15];
        float av = 0.f, dv = 0.f; if (tid < 128) { av = ACS[(size_t)task * 128 + tid]; dv = DTV[(size_t)task * 128 + tid]; }
        LDS_BARRIER();
#pragma unroll
        for (int i = 0; i < 4; ++i) { const int v = tid + 512 * i; *(u32x4*)(BmL + (v >> 4) * 136 + (v & 15) * 8) = gb[i]; }
#pragma unroll
        for (int i = 0; i < 2; ++i) { const int v = tid + 512 * i; *(u32x4*)(XdL + (v >> 4) * 136 + (v & 15) * 8) = gx[i]; *(u32x4*)(PvL + (v >> 4) * 136 + (v & 15) * 8) = gp[i]; }
        if (tid < 128) { acs[tid] = av; dtl[tid] = dv; }
        LDS_BARRIER();
        const int nst = (wid | 1) + 1;
        for (int st = 0; st < nst; ++st) {
            f32x4 cb = {0.f, 0.f, 0.f, 0.f};
#pragma unroll
            for (int k = 0; k < 4; ++k) { const bf16x8 bf = *(const bf16x8*)(BmL + (16 * st + l15) * 136 + k * 32 + lq * 8); cb = MFMA16(Cf[k], bf, cb); }
            const int sx = 16 * st + l15; const float as = acs[sx];
#pragma unroll
            for (int j = 0; j < 4; ++j) { const int ll = l0 + j; sc[(lq * 4 + j) * 136 + sx] = f2bf(ll >= sx ? cb[j] * __expf(acs[ll] - as) : 0.f); }
        }
        LDS_BARRIER();
        f32x4 yd[4], yo[4];
#pragma unroll
        for (int i = 0; i < 4; ++i) { yd[i] = (f32x4){0.f, 0.f, 0.f, 0.f}; yo[i] = (f32x4){0.f, 0.f, 0.f, 0.f}; }
        const int nks = (wid >> 1) + 1;
        for (int k = 0; k < nks; ++k) { const bf16x8 af = *(const bf16x8*)(sc + l15 * 136 + k * 32 + lq * 8);
#pragma unroll
            for (int pt = 0; pt < 4; ++pt) { const bf16x8 bf = *(const bf16x8*)(XdL + (16 * pt + l15) * 136 + k * 32 + lq * 8); yd[pt] = MFMA16(af, bf, yd[pt]); } }
#pragma unroll
        for (int k = 0; k < 4; ++k)
#pragma unroll
            for (int pt = 0; pt < 4; ++pt) { const bf16x8 bf = *(const bf16x8*)(PvL + (16 * pt + l15) * 136 + k * 32 + lq * 8); yo[pt] = MFMA16(Cf[k], bf, yo[pt]); }
        const float dh = dsk[h];
#pragma unroll
        for (int pt = 0; pt < 4; ++pt) { const int pp = 16 * pt + l15; const u32x2 xr = *(const u32x2*)(XdL + pp * 136 + l0);
            const float xd[4] = {lo_bf(xr[0]), hi_bf(xr[0]), lo_bf(xr[1]), hi_bf(xr[1])};
#pragma unroll
            for (int j = 0; j < 4; ++j) { const int ll = l0 + j; float y = yd[pt][j] + __expf(acs[ll]) * yo[pt][j] + dh * xd[j] / dtl[ll];
                y *= siluf_(bf2f(zz[pt][j]));
                YS[(row0 + ll) * 2048 + h * 64 + pp] = f2bf(y); } }
    }
}

__device__ __forceinline__ void ph_ssd_norm(const Params* lp_) {
    const int tid_ = otid(); const int wid = tid_ >> 6, lane = tid_ & 63;
    const bf16_t* YS = (const bf16_t*)(rflp(lp_->ws) + OFF_H); bf16_t* YN = (bf16_t*)(rflp(lp_->ws) + S_XDTT); const float* nw = rflp(lp_->in[32]);
    f32x4 nwv[8];
#pragma unroll
    for (int i = 0; i < 8; ++i) nwv[i] = *(const f32x4*)(nw + lane * 32 + i * 4);
    const int c0 = lane * 32; u32x4 nt[4]; int row = blockIdx.x * 8 + wid;
#pragma unroll
    for (int i = 0; i < 4; ++i) nt[i] = *(const u32x4*)(YS + (size_t)row * 2048 + c0 + i * 8);
    for (; row < M; row += gridDim.x * 8) {
        float y[32]; float ss = 0.f;
#pragma unroll
        for (int i = 0; i < 4; ++i) { const u32x4 t = nt[i];
#pragma unroll
            for (int j = 0; j < 4; ++j) { y[i * 8 + 2 * j] = lo_bf(t[j]); y[i * 8 + 2 * j + 1] = hi_bf(t[j]); } }
        if (row + (int)gridDim.x * 8 < M) {
#pragma unroll
            for (int i = 0; i < 4; ++i) nt[i] = *(const u32x4*)(YS + (size_t)(row + gridDim.x * 8) * 2048 + c0 + i * 8); }
#pragma unroll
        for (int i = 0; i < 32; ++i) ss += y[i] * y[i];
        ss += __shfl_xor(ss, 1, 64); ss += __shfl_xor(ss, 2, 64); ss += __shfl_xor(ss, 4, 64); ss += __shfl_xor(ss, 8, 64);
        const float inv = rsqrtf(ss * (1.f / 512.f) + 1e-5f);
#pragma unroll
        for (int i = 0; i < 8; ++i) { const f32x4 w = nwv[i];
#pragma unroll
            for (int j = 0; j < 4; ++j) y[i * 4 + j] *= inv * w[j]; }
#pragma unroll
        for (int i = 0; i < 4; ++i) *(bf16x8*)(YN + (size_t)row * 2048 + c0 + i * 8) = pack8(y + i * 8);
    }
}

__device__ __forceinline__ void ph_lru_conv(const Params* lp_) {
    const float* PROJ = (const float*)(rflp(lp_->ws) + L_PROJ); bf16_t* U = (bf16_t*)(rflp(lp_->ws) + L_U); const float* cw = rflp(lp_->in[35]); const float* cbias = rflp(lp_->in[36]);
    const int v0_ = blockIdx.x * 512 + otid(); const int cfix = (v0_ & 255) * 4;
    f32x4 cwv[4]; const f32x4 cbv = *(const f32x4*)(cbias + cfix);
#pragma unroll
    for (int j = 0; j < 4; ++j) cwv[j] = *(const f32x4*)(cw + j * 1024 + cfix);
    const int c = cfix; f32x4 nx[4]; int v = v0_;
#define CONV_LOAD(vv_) do { const int r_ = (vv_) >> 8, t_ = r_ & (T - 1); _Pragma("unroll") for (int j = 0; j < 4; ++j) { const int rj_ = (t_ - 3 + j) >= 0 ? r_ - 3 + j : r_; nx[j] = *(const f32x4*)(PROJ + (size_t)rj_ * 2048 + 1024 + c); } } while (0)
    CONV_LOAD(v);
    for (; v < M * 256; v += gridDim.x * 512) {
        const int row = v >> 8, t = row & (T - 1);
        f32x4 a = cbv;
#pragma unroll
        for (int j = 0; j < 4; ++j) { const float msk = (t - 3 + j) >= 0 ? 1.f : 0.f; a += (cwv[j] * msk) * nx[j]; }
        if (v + (int)gridDim.x * 512 < M * 256) CONV_LOAD(v + gridDim.x * 512);
        const u32x2 o = {cvt_pk_bf16(a[0], a[1]), cvt_pk_bf16(a[2], a[3])}; *(u32x2*)(U + (size_t)row * 1024 + c) = o;
    }
#undef CONV_LOAD
}
__device__ __forceinline__ void ph_lru_scan(unsigned char* shm, const Params* lp_) {
    float* segA = (float*)shm; float* segH = segA + 512;
    const float* AA = (const float*)(rflp(lp_->ws) + L_AA); const float* BB = (const float*)(rflp(lp_->ws) + L_BB); const float* PROJ = (const float*)(rflp(lp_->ws) + L_PROJ); bf16_t* YL = (bf16_t*)(rflp(lp_->ws) + OFF_XN);
    const int tid = otid(), chl = tid & 15, seg = tid >> 4;
    for (int item = blockIdx.x; item < 256; item += gridDim.x) {
        const int b = item >> 6, cg = item & 63, ch = cg * 16 + chl; const size_t base = ((size_t)b * T + seg * 128) * 1024 + ch;
        const size_t gbase = ((((size_t)b * 64 + cg) * 4096 + seg * 128) << 4) + chl;
        float A = 1.f, hh = 0.f;
        float na[8], nb[8], ng[8];
#pragma unroll
        for (int j = 0; j < 8; ++j) { na[j] = AA[gbase + (size_t)j * 16]; nb[j] = BB[gbase + (size_t)j * 16]; }
        for (int t8 = 0; t8 < 128; t8 += 8) {
            float ca[8], cb[8];
#pragma unroll
            for (int j = 0; j < 8; ++j) { ca[j] = na[j]; cb[j] = nb[j]; }
            if (t8 + 8 < 128) {
#pragma unroll
                for (int j = 0; j < 8; ++j) { na[j] = AA[gbase + (size_t)(t8 + 8 + j) * 16]; nb[j] = BB[gbase + (size_t)(t8 + 8 + j) * 16]; } }
#pragma unroll
            for (int j = 0; j < 8; ++j) { hh = ca[j] * hh + cb[j]; A *= ca[j]; }
        }
        __syncthreads();
        segA[seg * 16 + chl] = A; segH[seg * 16 + chl] = hh;
        __syncthreads();
        float hin = 0.f;
        for (int s = 0; s < seg; ++s) hin = segA[s * 16 + chl] * hin + segH[s * 16 + chl];
        hh = hin;
#pragma unroll
        for (int j = 0; j < 8; ++j) { na[j] = AA[gbase + (size_t)j * 16]; nb[j] = BB[gbase + (size_t)j * 16]; ng[j] = PROJ[((size_t)b * T + seg * 128 + j) * 2048 + ch]; }
        for (int t8 = 0; t8 < 128; t8 += 8) {
            float ca[8], cb[8], cg[8];
#pragma unroll
            for (int j = 0; j < 8; ++j) { ca[j] = na[j]; cb[j] = nb[j]; cg[j] = ng[j]; }
            if (t8 + 8 < 128) {
#pragma unroll
                for (int j = 0; j < 8; ++j) { na[j] = AA[gbase + (size_t)(t8 + 8 + j) * 16]; nb[j] = BB[gbase + (size_t)(t8 + 8 + j) * 16]; ng[j] = PROJ[((size_t)b * T + seg * 128 + t8 + 8 + j) * 2048 + ch]; } }
#pragma unroll
            for (int j = 0; j < 8; ++j) { hh = ca[j] * hh + cb[j]; YL[base + (size_t)(t8 + j) * 1024] = f2bf(gelu_tanh(cg[j]) * hh); }
        }
    }
}

#define XB_TMO      128
#define XB_XCNT(j)  (256  + 64 * (j))
#define XB_XSUB(j)  (1280 + 64 * (j))
#define XB_XGEN(j)  (2304 + 64 * (j))
#define XB_TOP      3328
#define XB_TOPGEN   3392
#define XCD_BAR_WORDS 3456
#define XB_SPIN_CAP (1u << 22)
__device__ __forceinline__ unsigned xb_ld(unsigned* p)              { return __hip_atomic_load(p, __ATOMIC_RELAXED, __HIP_MEMORY_SCOPE_AGENT); }
__device__ __forceinline__ unsigned xb_add(unsigned* p, unsigned v) { return __hip_atomic_fetch_add(p, v, __ATOMIC_RELAXED, __HIP_MEMORY_SCOPE_AGENT); }
__device__ __forceinline__ unsigned xb_xcc_id() { return (unsigned)__builtin_amdgcn_s_getreg((3 << 11) | 20) & 0xFu; }
#define XB_SPIN(cond, bar) do { unsigned _sp = 0; while (cond) { __builtin_amdgcn_s_sleep(1); \
    if ((++_sp & 255u) == 0u) { if (xb_ld(&(bar)[XB_TMO])) break; if (_sp > XB_SPIN_CAP) { atomicAdd(&(bar)[XB_TMO], 1u); break; } } } } while (0)
struct XcdBarrier { unsigned* bar; unsigned x; volatile LAS unsigned* st; };
__device__ __forceinline__ XcdBarrier xcd_barrier_post(unsigned* bar, volatile LAS unsigned* st) {
    XcdBarrier b; b.bar = bar; b.x = xb_xcc_id(); b.st = st;
    if (threadIdx.x == 0) (void)xb_add(&bar[XB_XCNT(b.x)], 1u);
    return b;
}
__device__ __forceinline__ void xcd_barrier_complete(unsigned* bar, unsigned x, unsigned& nloc, unsigned& nx) {
    const unsigned G = gridDim.x * gridDim.y * gridDim.z;
    unsigned sum, cnt, mine, sp = 0u;
    for (;;) {
        sum = 0u; cnt = 0u; mine = 0u;
#pragma unroll
        for (unsigned j = 0; j < 16; ++j) { const unsigned c = xb_ld(&bar[XB_XCNT(j)]); sum += c; cnt += (c > 0u) ? 1u : 0u; mine = (j == x) ? c : mine; }
        if (sum == G) break;
        __builtin_amdgcn_s_sleep(1);
        if ((++sp & 255u) == 0u) { if (xb_ld(&bar[XB_TMO])) break; if (sp > XB_SPIN_CAP) { atomicAdd(&bar[XB_TMO], 1u); break; } }
    }
    nloc = mine > 0u ? mine : 1u; nx = cnt > 0u ? cnt : 1u;
}
__device__ __forceinline__ void xcd_barrier(const XcdBarrier& b) {
    asm volatile("s_waitcnt vmcnt(0)" ::: "memory");
    __syncthreads();
    if (threadIdx.x == 0) {
        unsigned* bar = b.bar;
        __builtin_amdgcn_s_waitcnt(0);
        unsigned nloc = b.st[0], nx = b.st[1];
        if (nloc == 0u) { xcd_barrier_complete(bar, b.x, nloc, nx); b.st[0] = nloc; b.st[1] = nx; }
        const unsigned old = xb_add(&bar[XB_XSUB(b.x)], 1u);
        const unsigned gen = old / nloc;
        if (old + 1u == (gen + 1u) * nloc) {
            __builtin_amdgcn_fence(__ATOMIC_RELEASE, "agent");
            asm volatile("s_waitcnt vmcnt(0)" ::: "memory");
            const unsigned og = xb_add(&bar[XB_TOP], 1u);
            const unsigned tg = og / nx;
            if (og + 1u == (tg + 1u) * nx) xb_add(&bar[XB_TOPGEN], 1u);
            else XB_SPIN(xb_ld(&bar[XB_TOPGEN]) == tg, bar);
            __builtin_amdgcn_fence(__ATOMIC_ACQUIRE, "agent");
            xb_add(&bar[XB_XGEN(b.x)], 1u);
            asm volatile("s_waitcnt vmcnt(0)" ::: "memory");
        } else {
            XB_SPIN(xb_ld(&bar[XB_XGEN(b.x)]) == gen, bar);
            __builtin_amdgcn_fence(__ATOMIC_ACQUIRE, "agent");
            asm volatile("s_waitcnt vmcnt(0)" ::: "memory");
        }
    }
    __syncthreads();
}

enum { OP_FFN1 = 0, OP_FFN2, OP_ROW_A, OP_ROW_B, OP_ROW_M, OP_MIX_OUT, OP_GDN_IN, OP_GDN_PREP, OP_GDN_SCAN, OP_GDN_GATE, OP_RW_MIX, OP_RW_G1, OP_RW_G2, OP_RW_SCAN, OP_RW_POST,
       OP_SSD_IN, OP_SSD_PREP, OP_SSD_STATES, OP_SSD_CSCAN, OP_SSD_OUT, OP_SSD_NORM, OP_LRU_IN, OP_LRU_CONV, OP_LRU_GATES, OP_LRU_SCAN, OP_PREP, OP_END };
constexpr int LDS_PROG_OFF = LDS_DESC_OFF + 1024;
struct Step { int op, layer, half, d0, nd; };
struct Program { Step steps[72]; DescC descs[40]; };
constexpr DescC mk(size_t A, size_t Bt, size_t C, int lda, int ldb, int ldc, int K, int N, int epi, int perm, int aux = 0, int aux2 = 0, size_t side = 0) {
    return DescC{A, Bt, C, side, lda, ldb, ldc, K / BK, M / BM, N / BM, epi, perm, aux, aux2};
}
constexpr Program make_program() {
    Program P{}; int ns = 0, ndc = 0;
    P.steps[ns++] = Step{OP_PREP, 0, 0, 0, 0};
    for (int layer = 0; layer < 4; ++layer) {
        for (int half = 0; half < 2; ++half) {
            P.descs[ndc] = mk(OFF_XN, OFF_WF_IN + (layer * 2 + half) * SZ_WF_IN1, OFF_H, 1024, 1024, 2816, 1024, 5632, EPI_SWIGLU, 1);
            P.steps[ns++] = Step{OP_FFN1, layer, half, ndc++, 1};
            P.descs[ndc] = mk(OFF_H, OFF_WF_OUT + (layer * 2 + half) * SZ_WF_OUT1, OFF_Y, 2816, 2816, 1024, 2816, 1024, EPI_F32, 0);
            P.steps[ns++] = Step{OP_FFN2, layer, half, ndc++, 1};
            P.steps[ns++] = Step{half == 0 ? OP_ROW_A : OP_ROW_B, layer, half, 0, 0};
            if (half == 1) break;
            if (layer == 0) {
                P.descs[ndc] = mk(OFF_XN, OFF_W_GDN_IN, G_PROJ, 1024, 1024, 4352, 1024, 4352, EPI_BF16, 1, 16, 16, G_BA);
                P.steps[ns++] = Step{OP_GDN_IN, layer, 0, ndc++, 1};
                P.steps[ns++] = Step{OP_GDN_PREP, layer, 0, 0, 0}; P.steps[ns++] = Step{OP_GDN_SCAN, layer, 0, 0, 0}; P.steps[ns++] = Step{OP_GDN_GATE, layer, 0, 0, 0};
                P.descs[ndc] = mk(OFF_XN, OFF_W_GDN_OUT, OFF_Y, 1024, 1024, 1024, 1024, 1024, EPI_F32, 0);
            } else if (layer == 1) {
                P.steps[ns++] = Step{OP_RW_MIX, layer, 0, 0, 0};
                const int d0 = ndc;
                for (int i = 0; i < 3; ++i) P.descs[ndc++] = mk(R_XM + i * 1024 * 2, OFF_W_RKV + (size_t)i * 1024 * 1024 * 2, i == 0 ? OFF_Y : (i == 1 ? R_K : R_V), 6144, 1024, 1024, 1024, 1024, EPI_F32, 0);
                for (int i = 0; i < 3; ++i) P.descs[ndc++] = mk(R_XM + (3 + i) * 1024 * 2, OFF_W_L1 + (size_t)i * 256 * 1024 * 2, R_LOR, 6144, 1024, 256, 1024, 256, EPI_LORA1, 1, i);
                P.steps[ns++] = Step{OP_RW_G1, layer, 0, d0, 6};
                P.descs[ndc] = mk(R_LOR, OFF_W_L2, R_XM, 256, 256, 1024, 256, 3072, EPI_WAG, 0);
                P.steps[ns++] = Step{OP_RW_G2, layer, 0, ndc++, 1};
                P.steps[ns++] = Step{OP_RW_SCAN, layer, 0, 0, 0}; P.steps[ns++] = Step{OP_RW_POST, layer, 0, 0, 0};
                P.descs[ndc] = mk(OFF_XN, OFF_W_R_OUT, OFF_Y, 1024, 1024, 1024, 1024, 1024, EPI_F32, 0);
            } else if (layer == 2) {
                P.descs[ndc] = mk(OFF_XN, OFF_W_SSD_IN, S_PROJ, 1024, 1024, 5376, 1024, 5376, EPI_BF16, 1, 20, 32, S_DT);
                P.steps[ns++] = Step{OP_SSD_IN, layer, 0, ndc++, 1};
                P.steps[ns++] = Step{OP_SSD_PREP, layer, 0, 0, 0}; P.steps[ns++] = Step{OP_SSD_STATES, layer, 0, 0, 0}; P.steps[ns++] = Step{OP_SSD_CSCAN, layer, 0, 0, 0};
                P.steps[ns++] = Step{OP_SSD_OUT, layer, 0, 0, 0}; P.steps[ns++] = Step{OP_SSD_NORM, layer, 0, 0, 0};
                P.descs[ndc] = mk(S_XDTT, OFF_W_SSD_OUT, OFF_Y, 2048, 2048, 1024, 2048, 1024, EPI_F32, 0);
            } else {
                P.descs[ndc] = mk(OFF_XN, OFF_W_LRU_IN, L_PROJ, 1024, 1024, 2048, 1024, 2048, EPI_F32, 0);
                P.steps[ns++] = Step{OP_LRU_IN, layer, 0, ndc++, 1};
                P.steps[ns++] = Step{OP_LRU_CONV, layer, 0, 0, 0};
                const int d0 = ndc;
                for (int i = 0; i < 4; ++i) P.descs[ndc++] = mk(L_U + i * 256 * 2, OFF_W_LRU_G + (size_t)i * 512 * 256 * 2, 0, 1024, 256, 0, 256, 512, EPI_LRU, 0, i);
                P.steps[ns++] = Step{OP_LRU_GATES, layer, 0, d0, 4};
                P.steps[ns++] = Step{OP_LRU_SCAN, layer, 0, 0, 0};
                P.descs[ndc] = mk(OFF_XN, OFF_W_LRU_OUT, OFF_Y, 1024, 1024, 1024, 1024, 1024, EPI_F32, 0);
            }
            P.steps[ns++] = Step{OP_MIX_OUT, layer, 0, ndc++, 1};
            P.steps[ns++] = Step{OP_ROW_M, layer, 0, 0, 0};
        }
    }
    P.steps[ns++] = Step{OP_END, 0, 0, 0, 0};
    return P;
}
__constant__ Program PROGC = make_program();

__device__ __forceinline__ void weight_jobs(float* tile, const Params* lp_, int set, int bid, int nb) {
    unsigned char* ws = rflp(lp_->ws);
    for (int jq = 0; jq < 36; ++jq) {
        int myset = 2;
        if (jq < 4 || jq == 16 || jq == 17) myset = 0;
        else if ((jq >= 4 && jq < 8) || (jq >= 18 && jq <= 24) || jq >= 33) myset = 1;
        if (myset != set) continue;
        const float* src; int K, Ns, Nd, ldd, koff = 0, half = 0, rowoff = 0; bf16_t* dst;
        const int jb = jq - 16;
        if (jq < 16) { const int i = jq >> 1;
            if ((jq & 1) == 0) { src = rflp(lp_->in[2]) + (size_t)i * 1024 * 5632; K = 1024; Ns = 5632; Nd = 5632; dst = (bf16_t*)(ws + OFF_WF_IN + i * SZ_WF_IN1); ldd = 1024; half = 2816; }
            else { src = rflp(lp_->in[3]) + (size_t)i * 2816 * 1024; K = 2816; Ns = 1024; Nd = 1024; dst = (bf16_t*)(ws + OFF_WF_OUT + i * SZ_WF_OUT1); ldd = 2816; } }
        else switch (jb) {
            case 0: src = rflp(lp_->in[4]); K = 1024; Ns = 4112; Nd = 4352; dst = (bf16_t*)(ws + OFF_W_GDN_IN); ldd = 1024; break;
            case 1: src = rflp(lp_->in[9]); K = 1024; Ns = 1024; Nd = 1024; dst = (bf16_t*)(ws + OFF_W_GDN_OUT); ldd = 1024; break;
            case 2: case 3: case 4: src = rflp(lp_->in[11]) + (size_t)(jb - 2) * 1024 * 1024; K = 1024; Ns = 1024; Nd = 1024; dst = (bf16_t*)(ws + OFF_W_RKV) + (size_t)(jb - 2) * 1024 * 1024; ldd = 1024; break;
            case 5: src = rflp(lp_->in[13]); K = 1024; Ns = 64; Nd = 64; dst = (bf16_t*)(ws + OFF_W_L1); ldd = 1024; break;
            case 6: src = rflp(lp_->in[16]); K = 1024; Ns = 64; Nd = 64; dst = (bf16_t*)(ws + OFF_W_L1) + 256 * 1024; ldd = 1024; break;
            case 7: src = rflp(lp_->in[18]); K = 1024; Ns = 128; Nd = 128; dst = (bf16_t*)(ws + OFF_W_L1) + 2 * 256 * 1024; ldd = 1024; break;
            case 8: src = rflp(lp_->in[25]); K = 1024; Ns = 1024; Nd = 1024; dst = (bf16_t*)(ws + OFF_W_R_OUT); ldd = 1024; break;
            case 9: src = rflp(lp_->in[26]); K = 1024; Ns = 5152; Nd = 5376; dst = (bf16_t*)(ws + OFF_W_SSD_IN); ldd = 1024; break;
            case 10: src = rflp(lp_->in[33]); K = 2048; Ns = 1024; Nd = 1024; dst = (bf16_t*)(ws + OFF_W_SSD_OUT); ldd = 2048; break;
            case 11: src = rflp(lp_->in[34]); K = 1024; Ns = 2048; Nd = 2048; dst = (bf16_t*)(ws + OFF_W_LRU_IN); ldd = 1024; break;
            case 12: case 13: case 14: case 15: src = rflp(lp_->in[37]) + (size_t)(jb - 12) * 256 * 512; K = 256; Ns = 512; Nd = 512; dst = (bf16_t*)(ws + OFF_W_LRU_G) + (size_t)(jb - 12) * 512 * 256; ldd = 256; half = 256; break;
            case 16: src = rflp(lp_->in[40]); K = 1024; Ns = 1024; Nd = 1024; dst = (bf16_t*)(ws + OFF_W_LRU_OUT); ldd = 1024; break;
            case 17: src = rflp(lp_->in[14]); K = 64; Ns = 1024; Nd = 1024; dst = (bf16_t*)(ws + OFF_W_L2); ldd = 256; break;
            case 18: src = rflp(lp_->in[17]); K = 64; Ns = 1024; Nd = 1024; dst = (bf16_t*)(ws + OFF_W_L2); ldd = 256; koff = 64; rowoff = 1024; break;
            default: src = rflp(lp_->in[19]); K = 128; Ns = 1024; Nd = 1024; dst = (bf16_t*)(ws + OFF_W_L2); ldd = 256; koff = 128; rowoff = 2048; break;
        }
        tr_job(tile, src, K, Ns, Nd, dst, ldd, koff, half, rowoff, bid, nb);
    }
    { bf16_t* z = (bf16_t*)(ws + OFF_W_L2);
      if (set == 1) for (int v = bid * 512 + otid(); v < 3072 * 32; v += nb * 512) { const int row = v >> 5, c8 = (v & 31) * 8; const int blk = row >> 10;
          const bool used = blk == 0 ? (c8 < 64) : (blk == 1 ? (c8 >= 64 && c8 < 128) : (c8 >= 128));
          if (!used) { unsigned zz = 0u; asm volatile("" : "+v"(zz)); *(u32x4*)(z + (size_t)row * 256 + c8) = (u32x4){zz, zz, zz, zz}; } } }
}

__global__ void __launch_bounds__(512) mega(Params p) {
    extern __shared__ __attribute__((aligned(16))) unsigned char shm[];
    cg::grid_group grid = cg::this_grid();
    LAS unsigned char* lds = (LAS unsigned char*)shm;
    Params* lp = (Params*)(shm + LDS_PROG_OFF + 256);
    if (threadIdx.x == 0) {
#pragma unroll
        for (int i = 0; i < 41; ++i) lp->in[i] = p.in[i];
        lp->out = p.out; lp->ws = p.ws;
    }
    volatile LAS unsigned* xst = (volatile LAS unsigned*)(lds + LDS_PROG_OFF + 1024);
    if (threadIdx.x == 0) { xst[0] = 0u; xst[1] = 0u; xst[2] = 0u; xst[3] = 0u; }
    __syncthreads();
    (void)xcd_barrier_post((unsigned*)(rflp(lp->ws) + OFF_BAR), xst);
    for (int pc = 0, rrep = 0;; ++pc) {
        const Step* st = &PROGC.steps[pc];
        const int op = rfl(st->op), layer = rfl(st->layer), d0 = rfl(st->d0), nd = rfl(st->nd);
        if (op == OP_END) break;
        if (nd) gemm_phase(lds, &PROGC.descs[d0], nd, lp);
        else if (op == OP_PREP) {
            unsigned char* ws = rflp(lp->ws);
            weight_jobs((float*)shm, lp, 0, blockIdx.x, gridDim.x);
            ph_firstnorm(rflp(lp->in[0]), rflp(lp->out), rflp(lp->in[1]), (bf16_t*)(ws + OFF_XN));
        } else if (op == OP_ROW_A || op == OP_ROW_B || op == OP_ROW_M) {
            unsigned char* ws = rflp(lp->ws);
            const float* g = rflp(lp->in[1]) + (size_t)layer * 6 * 1024;
            const int ia = op == OP_ROW_A ? 1 : (op == OP_ROW_M ? 3 : 5);
            const bool has_gb = !(op == OP_ROW_B && layer == 3);
            ph_rowpass(rflp(lp->out), (const float*)(ws + OFF_Y), op == OP_ROW_M ? 1.f : 0.5f, g + ia * 1024, g + (has_gb ? ia + 1 : ia) * 1024, (bf16_t*)(ws + OFF_XN), has_gb);
        } else switch (op) {
            case OP_GDN_PREP: ph_gdn_prep(shm, lp); break;
            case OP_GDN_SCAN: if (blockIdx.x < 128) ph_gdn_scan(shm, lp); else weight_jobs((float*)shm, lp, 1, blockIdx.x - 128, gridDim.x - 128); break;
            case OP_GDN_GATE: ph_gdn_gate(lp); break;
            case OP_RW_MIX: ph_rwkv_mix(lp); break;
            case OP_RW_SCAN: ph_rwkv_scan(shm, lp); break;
            case OP_RW_POST: ph_rwkv_post(lp); break;
            case OP_SSD_PREP: ph_ssd_prep(shm, lp); break;
            case OP_SSD_STATES: ph_ssd_states(shm, lp); break;
            case OP_SSD_CSCAN: ph_ssd_chunkscan(lp); break;
            case OP_SSD_OUT: ph_ssd_out(shm, lp); break;
            case OP_SSD_NORM: ph_ssd_norm(lp); break;
            case OP_LRU_CONV: ph_lru_conv(lp); break;
            case OP_LRU_SCAN: ph_lru_scan(shm, lp); break;
            default: break;
        }
#ifdef PROBE_REP
        { int rep = 1; PROBE_REP; if (rrep + 1 < rep) { ++rrep; --pc; } else rrep = 0; }
#endif
        if (lp->ws == nullptr) grid.sync();
        { XcdBarrier xb; xb.bar = (unsigned*)(rflp(lp->ws) + OFF_BAR); xb.x = xb_xcc_id(); xb.st = xst; xcd_barrier(xb); }
    }
}

extern "C" void kernel_launch(void* const* d_in, const int* in_sizes, int n_in, void* d_out, int out_size, void* d_ws, size_t ws_size, hipStream_t stream) {
    if (ws_size < WS_NEED) { fprintf(stderr, "workspace too small: %zu < %zu\n", ws_size, (size_t)WS_NEED); return; }
    static int grid_blocks = 0;
    if (!grid_blocks) {
        (void)hipFuncSetAttribute((const void*)mega, hipFuncAttributeMaxDynamicSharedMemorySize, LDS_BYTES);
        int dev = 0, cus = 0, per_cu = 0;
        (void)hipGetDevice(&dev);
        (void)hipDeviceGetAttribute(&cus, hipDeviceAttributeMultiprocessorCount, dev);
        (void)hipOccupancyMaxActiveBlocksPerMultiprocessor(&per_cu, mega, 512, LDS_BYTES);
        if (per_cu < 1) per_cu = 1;
        grid_blocks = cus;
    }
    Params p{};
    for (int i = 0; i < 41; ++i) p.in[i] = (const float*)d_in[i];
    p.out = (float*)d_out; p.ws = (unsigned char*)d_ws;
    void* args[] = {&p};
    (void)hipMemsetAsync((unsigned char*)d_ws + OFF_BAR, 0, 3456 * 4, stream);
    hipError_t e = hipLaunchCooperativeKernel((void*)mega, dim3(grid_blocks), dim3(512), args, LDS_BYTES, stream);
    if (e != hipSuccess) fprintf(stderr, "cooperative launch failed: %s (grid %d)\n", hipGetErrorString(e), grid_blocks);
}
```

```cpp
#include <hip/hip_runtime.h>
#include <hip/hip_cooperative_groups.h>
#include <cstdio>
namespace cg = cooperative_groups;

#define LAS __attribute__((address_space(3)))
typedef unsigned short bf16_t;
typedef short bf16x8 __attribute__((ext_vector_type(8)));
typedef float f32x4 __attribute__((ext_vector_type(4)));
typedef unsigned u32x4 __attribute__((ext_vector_type(4)));
typedef unsigned u32x2 __attribute__((ext_vector_type(2)));

constexpr int M = 16384, T = 4096, NB = 4, D = 1024, DFF = 2816;
constexpr size_t MS = 16384;

constexpr size_t OFF_WF_IN = 0;
constexpr size_t SZ_WF_IN1 = 5632ull * 1024 * 2;
constexpr size_t OFF_WF_OUT = OFF_WF_IN + 8 * SZ_WF_IN1;
constexpr size_t SZ_WF_OUT1 = 1024ull * 2816 * 2;
constexpr size_t OFF_W_GDN_IN = OFF_WF_OUT + 8 * SZ_WF_OUT1;
constexpr size_t OFF_W_GDN_OUT = OFF_W_GDN_IN + 4352ull * 1024 * 2;
constexpr size_t OFF_W_RKV = OFF_W_GDN_OUT + 1024ull * 1024 * 2;
constexpr size_t OFF_W_L1 = OFF_W_RKV + 3 * 1024ull * 1024 * 2;
constexpr size_t OFF_W_L2 = OFF_W_L1 + 3 * 256ull * 1024 * 2;
constexpr size_t OFF_W_R_OUT = OFF_W_L2 + 3072ull * 256 * 2;
constexpr size_t OFF_W_SSD_IN = OFF_W_R_OUT + 1024ull * 1024 * 2;
constexpr size_t OFF_W_SSD_OUT = OFF_W_SSD_IN + 5376ull * 1024 * 2;
constexpr size_t OFF_W_LRU_IN = OFF_W_SSD_OUT + 1024ull * 2048 * 2;
constexpr size_t OFF_W_LRU_G = OFF_W_LRU_IN + 2048ull * 1024 * 2;
constexpr size_t OFF_W_LRU_OUT = OFF_W_LRU_G + 4 * 512ull * 256 * 2;
constexpr size_t OFF_XN = OFF_W_LRU_OUT + 1024ull * 1024 * 2;
constexpr size_t OFF_H = OFF_XN + MS * 1024 * 2;
constexpr size_t OFF_Y = OFF_H + MS * 2816 * 2;
constexpr size_t OFF_MX = OFF_Y + MS * 1024 * 4;
constexpr size_t G_PROJ = OFF_MX;
constexpr size_t G_BA = G_PROJ + MS * 4352 * 2;
constexpr size_t G_WB = G_BA + MS * 16 * 4;
constexpr size_t G_QD = G_WB + 2048ull * 64 * 128 * 2;
constexpr size_t G_QK = G_QD + 2048ull * 64 * 128 * 2;
constexpr size_t G_KDT = G_QK + 2048ull * 64 * 64 * 2;
constexpr size_t G_GL = G_KDT + 2048ull * 128 * 64 * 2;
constexpr size_t G_END = G_GL + 2048 * 4;
constexpr size_t R_XM = OFF_MX;
constexpr size_t R_K = R_XM + MS * 6144 * 2;
constexpr size_t R_V = R_K + MS * 1024 * 4;
constexpr size_t R_LOR = R_V + MS * 1024 * 4;
constexpr size_t R_END = R_LOR + MS * 256 * 2;
constexpr size_t S_PROJ = OFF_MX;
constexpr size_t S_DT = S_PROJ + MS * 5376 * 2;
constexpr size_t S_BCN = S_DT + MS * 32 * 4;
constexpr size_t S_XDTT = S_BCN + MS * 1024 * 2;
constexpr size_t S_BMT = S_XDTT + MS * 2048 * 2;
constexpr size_t S_DTV = S_BMT + MS * 512 * 2;
constexpr size_t S_ACS = S_DTV + MS * 32 * 4;
constexpr size_t S_END = S_ACS + MS * 32 * 4;
constexpr size_t L_PROJ = OFF_MX;
constexpr size_t L_U = L_PROJ + MS * 2048 * 4;
constexpr size_t L_AA = L_U + MS * 1024 * 2;
constexpr size_t L_BB = L_AA + MS * 1024 * 4;
constexpr size_t L_END = L_BB + MS * 1024 * 4;
constexpr size_t cmax(size_t a, size_t b) { return a > b ? a : b; }
constexpr size_t OFF_BAR = cmax(cmax(G_END, R_END), cmax(S_END, L_END));
constexpr size_t WS_NEED = OFF_BAR + 3456 * 4;

constexpr int LDS_BYTES = 160 * 1024;
constexpr int LDS_DESC_OFF = 128 * 1024;

struct Params { const float* in[41]; float* out; unsigned char* ws; };

__device__ __forceinline__ int otid() { int t = threadIdx.x; asm volatile("" : "+v"(t)); return t; }
__device__ __forceinline__ bf16_t f2bf(float f) { unsigned u = __float_as_uint(f); u += 0x7FFFu + ((u >> 16) & 1u); return (bf16_t)(u >> 16); }
__device__ __forceinline__ float bf2f(bf16_t b) { return __uint_as_float(((unsigned)b) << 16); }
__device__ __forceinline__ unsigned cvt_pk_bf16(float lo, float hi) { unsigned r; asm("v_cvt_pk_bf16_f32 %0, %1, %2" : "=v"(r) : "v"(lo), "v"(hi)); return r; }
__device__ __forceinline__ float lo_bf(unsigned u) { return __uint_as_float(u << 16); }
__device__ __forceinline__ float hi_bf(unsigned u) { return __uint_as_float(u & 0xFFFF0000u); }
__device__ __forceinline__ float sigmoidf_(float x) { return __builtin_amdgcn_rcpf(1.f + __expf(-x)); }
__device__ __forceinline__ float siluf_(float x) { return x * __builtin_amdgcn_rcpf(1.f + __expf(-x)); }
__device__ __forceinline__ float softplusf_(float x) { return fmaxf(x, 0.f) + log1pf(__expf(-fabsf(x))); }
__device__ __forceinline__ float tanhf_(float x) { float e = __expf(2.f * x); return 1.f - 2.f * __builtin_amdgcn_rcpf(1.f + e); }
__device__ __forceinline__ float gelu_tanh(float x) { return 0.5f * x * (1.f + tanhf_(0.7978845608028654f * (x + 0.044715f * x * x * x))); }
__device__ __forceinline__ float wave_sum(float v) {
#pragma unroll
    for (int o = 32; o > 0; o >>= 1) v += __shfl_xor(v, o, 64);
    return v;
}
template <int CTRL> __device__ __forceinline__ float dpp_f(float x) { return __builtin_bit_cast(float, __builtin_amdgcn_update_dpp(0, __builtin_bit_cast(int, x), CTRL, 0xF, 0xF, true)); }
__device__ __forceinline__ float dpp_sum16(float x) {
    x += dpp_f<0xB1>(x); x += dpp_f<0x4E>(x); x += dpp_f<0x141>(x); x += dpp_f<0x140>(x); return x;
}
__device__ __forceinline__ bf16x8 pack8(const float* v) {
    const u32x4 r = {cvt_pk_bf16(v[0], v[1]), cvt_pk_bf16(v[2], v[3]), cvt_pk_bf16(v[4], v[5]), cvt_pk_bf16(v[6], v[7])};
    return __builtin_bit_cast(bf16x8, r);
}
__device__ __forceinline__ bf16x8 pack8v(f32x4 a, f32x4 b) {
    const u32x4 r = {cvt_pk_bf16(a[0], a[1]), cvt_pk_bf16(a[2], a[3]), cvt_pk_bf16(b[0], b[1]), cvt_pk_bf16(b[2], b[3])};
    return __builtin_bit_cast(bf16x8, r);
}
#define LDS_BARRIER() do { asm volatile("s_waitcnt lgkmcnt(0)" ::: "memory"); __builtin_amdgcn_s_barrier(); asm volatile("" ::: "memory"); } while (0)
#define MFMA16(a, b, c) __builtin_amdgcn_mfma_f32_16x16x32_bf16((a), (b), (c), 0, 0, 0)

constexpr int BM = 256, BK = 64, HALF = 128, HTB = HALF * BK * 2, NXCD = 8, WGM = 8;
__device__ __forceinline__ int lds_byte(int r, int c) { const int st = (r >> 4) * 2 + (c >> 5), rr = r & 15, cc = c & 31, ob = rr * 64 + cc * 2; return st * 1024 + (ob ^ (((ob >> 9) & 1) << 5)); }
__device__ __forceinline__ void stage_rc(int b, int& R, int& C) { const int st = b / 1024, sb = b % 1024, swz = sb ^ (((sb >> 9) & 1) << 5); R = (st >> 1) * 16 + swz / 64; C = (st & 1) * 32 + (swz % 64) / 2; }
__device__ __forceinline__ int perm32(int rho) { const int n = rho >> 4, i = rho & 15; return 8 * (i >> 2) + 4 * n + (i & 3); }

enum { EPI_F32 = 0, EPI_SWIGLU = 1, EPI_BF16 = 2, EPI_LORA1 = 3, EPI_WAG = 4, EPI_LRU = 5 };
struct GDesc { const bf16_t* A; const bf16_t* Bt; void* C; int lda, ldb, ldc, nt, nM, nN, epi, perm, aux, aux2; float* side; };
struct Unit { int d, pm, pn; };
struct DescC { unsigned long long offA, offB, offC, offSide; int lda, ldb, ldc, nt, nM, nN, epi, perm, aux, aux2; };

__device__ __forceinline__ int rfl(int v) { return __builtin_amdgcn_readfirstlane(v); }
template <class P> __device__ __forceinline__ P* rflp(P* p) { unsigned long long u = (unsigned long long)p; unsigned lo = (unsigned)rfl((int)(unsigned)u), hi = (unsigned)rfl((int)(unsigned)(u >> 32)); return (P*)(__attribute__((address_space(1))) P*)(((unsigned long long)hi << 32) | lo); }
__device__ __forceinline__ Params load_params(const Params* q) {
    Params r;
#pragma unroll
    for (int i = 0; i < 41; ++i) r.in[i] = rflp(q->in[i]);
    r.out = rflp(q->out); r.ws = rflp(q->ws); return r;
}
__device__ __forceinline__ unsigned long long rfl64(unsigned long long u) { unsigned lo = (unsigned)rfl((int)(unsigned)u), hi = (unsigned)rfl((int)(unsigned)(u >> 32)); return ((unsigned long long)hi << 32) | lo; }
__device__ __forceinline__ GDesc load_desc(const DescC* q, unsigned char* ws) {
    GDesc d; d.A = (const bf16_t*)(ws + rfl64(q->offA)); d.Bt = (const bf16_t*)(ws + rfl64(q->offB)); d.C = (void*)(ws + rfl64(q->offC)); d.side = (float*)(ws + rfl64(q->offSide));
    d.lda = rfl(q->lda); d.ldb = rfl(q->ldb); d.ldc = rfl(q->ldc); d.nt = rfl(q->nt); d.nM = rfl(q->nM); d.nN = rfl(q->nN);
    d.epi = rfl(q->epi); d.perm = rfl(q->perm); d.aux = rfl(q->aux); d.aux2 = rfl(q->aux2); return d;
}
__device__ __forceinline__ bool next_unit(const DescC* descs, int nd, int i, Unit& u) {
    long L = (long)i * gridDim.x + blockIdx.x; int d = 0;
    for (; d < nd; ++d) { const int n = rfl(descs[d].nM * descs[d].nN); if (L < n) break; L -= n; }
    if (d >= nd) return false;
    const int nM = rfl(descs[d].nM), nN = rfl(descs[d].nN), nwg = nM * nN; int wgid = (int)L;
    { const int q = nwg / NXCD, r = nwg % NXCD, xcd = wgid % NXCD, off = wgid / NXCD; wgid = (xcd < r ? xcd * (q + 1) : r * (q + 1) + (xcd - r) * q) + off; }
    const int nig = WGM * nN, gid = wgid / nig, fm = gid * WGM, gsz = (nM - fm) < WGM ? (nM - fm) : WGM;
    u.d = d; u.pm = fm + ((wgid % nig) % gsz); u.pn = (wgid % nig) / gsz; return true;
}

__device__ __forceinline__ void gemm_epilogue(const f32x4 (&acc)[2][2][4][2], const GDesc& d, const Unit& u, int wr, int wc, int fr, int fq, const Params* lp_) {
    const int row0 = u.pm * BM + wr * 64 + fr;
    if (d.epi == EPI_F32) {
        float* C = (float*)d.C; const int col0 = u.pn * BM + wc * 32 + 4 * fq;
#pragma unroll
        for (int ai = 0; ai < 2; ++ai)
#pragma unroll
            for (int m = 0; m < 4; ++m) { float* rowp = C + (size_t)(row0 + ai * HALF + m * 16) * d.ldc + col0;
#pragma unroll
                for (int bj = 0; bj < 2; ++bj)
#pragma unroll
                    for (int n = 0; n < 2; ++n) *(f32x4*)(rowp + bj * HALF + n * 16) = acc[ai][bj][m][n]; }
    } else if (d.epi == EPI_SWIGLU) {
        bf16_t* C = (bf16_t*)d.C; const int col0 = u.pn * 128 + wc * 32 + 8 * fq;
#pragma unroll
        for (int ai = 0; ai < 2; ++ai)
#pragma unroll
            for (int m = 0; m < 4; ++m) {
                const f32x4 g0 = acc[ai][0][m][0], u0 = acc[ai][1][m][0], g1 = acc[ai][0][m][1], u1 = acc[ai][1][m][1];
                const u32x4 o = {cvt_pk_bf16(siluf_(g0[0]) * u0[0], siluf_(g0[1]) * u0[1]), cvt_pk_bf16(siluf_(g0[2]) * u0[2], siluf_(g0[3]) * u0[3]),
                                 cvt_pk_bf16(siluf_(g1[0]) * u1[0], siluf_(g1[1]) * u1[1]), cvt_pk_bf16(siluf_(g1[2]) * u1[2], siluf_(g1[3]) * u1[3])};
                *(u32x4*)(C + (size_t)(row0 + ai * HALF + m * 16) * d.ldc + col0) = o; }
    } else if (d.epi == EPI_BF16) {
        bf16_t* C = (bf16_t*)d.C; const int colt = wc * 32 + 8 * fq; const bool side = (u.pn == d.aux);
#pragma unroll
        for (int ai = 0; ai < 2; ++ai)
#pragma unroll
            for (int m = 0; m < 4; ++m) { const size_t row = (size_t)(row0 + ai * HALF + m * 16);
#pragma unroll
                for (int bj = 0; bj < 2; ++bj) { const f32x4 v0 = acc[ai][bj][m][0], v1 = acc[ai][bj][m][1];
                    const u32x4 o = {cvt_pk_bf16(v0[0], v0[1]), cvt_pk_bf16(v0[2], v0[3]), cvt_pk_bf16(v1[0], v1[1]), cvt_pk_bf16(v1[2], v1[3])};
                    *(u32x4*)(C + row * d.ldc + u.pn * BM + bj * HALF + colt) = o;
                    if (side && (bj * HALF + colt) < d.aux2) { float* sp = d.side + row * d.aux2 + bj * HALF + colt; *(f32x4*)sp = v0; *(f32x4*)(sp + 4) = v1; } } }
    } else if (d.epi == EPI_LORA1) {
        bf16_t* C = (bf16_t*)d.C; const int which = d.aux; const int ncol = which == 2 ? 128 : 64, coff = which * 64;
#pragma unroll
        for (int ai = 0; ai < 2; ++ai)
#pragma unroll
            for (int m = 0; m < 4; ++m) { const size_t row = (size_t)(row0 + ai * HALF + m * 16);
#pragma unroll
                for (int bj = 0; bj < 2; ++bj) { const int c0 = bj * HALF + wc * 32 + 8 * fq;
                    if (c0 < ncol) { float v[8];
#pragma unroll
                        for (int n = 0; n < 2; ++n)
#pragma unroll
                            for (int j = 0; j < 4; ++j) { float a = acc[ai][bj][m][n][j]; v[n * 4 + j] = which == 0 ? tanhf_(a) : (which == 1 ? a : sigmoidf_(a)); }
                        *(bf16x8*)(C + row * 256 + coff + c0) = pack8(v); } } }
    } else if (d.epi == EPI_WAG) {
        float* C = (float*)d.C; const int which = u.pn >> 2; const int cb = (u.pn & 3) * BM + wc * 32 + 4 * fq;
        const float* bp = which == 0 ? rflp(lp_->in[12]) : rflp(lp_->in[15]);
        f32x4 bv[2][2];
#pragma unroll
        for (int bj = 0; bj < 2; ++bj)
#pragma unroll
            for (int n = 0; n < 2; ++n) bv[bj][n] = which < 2 ? *(const f32x4*)(bp + cb + bj * HALF + n * 16) : (f32x4){0.f, 0.f, 0.f, 0.f};
#pragma unroll
        for (int ai = 0; ai < 2; ++ai)
#pragma unroll
            for (int m = 0; m < 4; ++m) { const size_t row = (size_t)(row0 + ai * HALF + m * 16);
#pragma unroll
                for (int bj = 0; bj < 2; ++bj)
#pragma unroll
                    for (int n = 0; n < 2; ++n) { const int c = cb + bj * HALF + n * 16; f32x4 v = acc[ai][bj][m][n]; const f32x4 bb = bv[bj][n];
                        if (which == 0) {
#pragma unroll
                            for (int j = 0; j < 4; ++j) { const float wl = -softplusf_(-(bb[j] + v[j])) - 0.5f; v[j] = __expf(-__expf(wl)); } }
                        else if (which == 1) {
#pragma unroll
                            for (int j = 0; j < 4; ++j) v[j] = sigmoidf_(bb[j] + v[j]); }
                        *(f32x4*)(C + (size_t)which * MS * 1024 + row * 1024 + c) = v; } }
    } else {
        const int blk = d.aux; const int chb = blk * 256 + u.pn * 128 + wc * 32 + 4 * fq;
        const float* b0 = rflp(lp_->in[38]); const float* b1 = b0 + 1024; const float* lam = rflp(lp_->in[39]);
        const bf16_t* U = (const bf16_t*)(rflp(lp_->ws) + L_U); float* AA = (float*)(rflp(lp_->ws) + L_AA); float* BB = (float*)(rflp(lp_->ws) + L_BB);
        f32x4 vb0[2], vb1[2], spl[2];
#pragma unroll
        for (int n = 0; n < 2; ++n) { vb0[n] = *(const f32x4*)(b0 + chb + n * 16); vb1[n] = *(const f32x4*)(b1 + chb + n * 16); spl[n] = *(const f32x4*)(lam + chb + n * 16); }
#pragma unroll
        for (int n = 0; n < 2; ++n)
#pragma unroll
            for (int j = 0; j < 4; ++j) spl[n][j] = -8.f * softplusf_(-spl[n][j]);
#pragma unroll
        for (int ai = 0; ai < 2; ++ai) {
            u32x2 uu[4][2];
#pragma unroll
            for (int m = 0; m < 4; ++m)
#pragma unroll
                for (int n = 0; n < 2; ++n) uu[m][n] = *(const u32x2*)(U + (size_t)(row0 + ai * HALF + m * 16) * 1024 + chb + n * 16);
#pragma unroll
            for (int m = 0; m < 4; ++m) { const size_t row = (size_t)(row0 + ai * HALF + m * 16); const unsigned rowb = ((((unsigned)row >> 12) << 18) + ((unsigned)row & 4095u)) << 4;
#pragma unroll
                for (int n = 0; n < 2; ++n) { const f32x4 rr = acc[ai][0][m][n], ii = acc[ai][1][m][n];
                    const u32x2 ux = uu[m][n]; const float uf[4] = {lo_bf(ux[0]), hi_bf(ux[0]), lo_bf(ux[1]), hi_bf(ux[1])};
                    f32x4 oa = {0.f, 0.f, 0.f, 0.f}, ob = {0.f, 0.f, 0.f, 0.f};
#pragma unroll
                    for (int j = 0; j < 4; ++j) { const float r = sigmoidf_(rr[j] + vb0[n][j]), ig = sigmoidf_(ii[j] + vb1[n][j]); const float la = r * spl[n][j];
                        oa[j] = __expf(la); ob[j] = sqrtf(fmaxf(-expm1f(2.f * la), 0.f)) * (ig * uf[j]); }
                    const unsigned gi = rowb + (((unsigned)(chb >> 4) + (unsigned)n) << 16) + (unsigned)(chb & 15);
                    *(f32x4*)(AA + gi) = oa; *(f32x4*)(BB + gi) = ob; } } }
    }
}

struct UP { const char* A; const char* B; unsigned lda2, ldb2, hA, hB, perm; };
__device__ __forceinline__ void unit_setup(UP& o, const GDesc& d, const Unit& u) {
    o.lda2 = (unsigned)d.lda * 2u; o.ldb2 = (unsigned)d.ldb * 2u; o.perm = (unsigned)d.perm;
    o.hA = (unsigned)HALF * o.lda2; o.hB = (unsigned)HALF * o.ldb2;
    o.A = (const char*)d.A + (size_t)u.pm * 2 * o.hA; o.B = (const char*)d.Bt + (size_t)u.pn * 2 * o.hB;
}

__device__ __forceinline__ void gemm_phase(LAS unsigned char* lds, const DescC* descs, int nd, const Params* lp_) {
    unsigned char* wsb = rflp(lp_->ws);
    const int tid = otid(), wid = __builtin_amdgcn_readfirstlane(tid >> 6), lane = tid & 63, wr = wid >> 2, wc = wid & 3, fr = lane & 15, fq = lane >> 4;
    int R0, C0, R1, C1; stage_rc(tid * 16, R0, C0); stage_rc(tid * 16 + 8192, R1, C1);
    const int Rp0 = (R0 & ~31) + perm32(R0 & 31), Rp1 = (R1 & ~31) + perm32(R1 & 31);
    const unsigned C0b = (unsigned)C0 * 2u, C1b = (unsigned)C1 * 2u;
    const size_t kstep = (size_t)(BK * 2);
    const unsigned ldsw = (unsigned)wid * 1024u;
    const int aoff = lds_byte(wr * 64 + fr, fq * 8), boff = lds_byte(wc * 32 + fr, fq * 8);
#define G_SA(b, h) (((b) * 2 + (h)) * HTB)
#define G_SB(b, h) ((4 + (b) * 2 + (h)) * HTB)
#define G_STAGE_A(bufoff, gbase, U) do { \
        __builtin_amdgcn_global_load_lds((const unsigned*)((const char*)(gbase) + ((unsigned)R0 * (U).lda2 + C0b)), (LAS unsigned*)(lds + (bufoff) + ldsw), 16, 0, 0); \
        __builtin_amdgcn_global_load_lds((const unsigned*)((const char*)(gbase) + ((unsigned)R1 * (U).lda2 + C1b)), (LAS unsigned*)(lds + (bufoff) + ldsw + 8192), 16, 0, 0); } while (0)
#define G_STAGE_B(bufoff, gbase, U) do { \
        __builtin_amdgcn_global_load_lds((const unsigned*)((const char*)(gbase) + ((unsigned)((U).perm ? Rp0 : R0) * (U).ldb2 + C0b)), (LAS unsigned*)(lds + (bufoff) + ldsw), 16, 0, 0); \
        __builtin_amdgcn_global_load_lds((const unsigned*)((const char*)(gbase) + ((unsigned)((U).perm ? Rp1 : R1) * (U).ldb2 + C1b)), (LAS unsigned*)(lds + (bufoff) + ldsw + 8192), 16, 0, 0); } while (0)
#define G_LDA(dst, b, h) do { _Pragma("unroll") for (int m = 0; m < 4; ++m) _Pragma("unroll") for (int k = 0; k < 2; ++k) dst[m][k] = *(const LAS bf16x8*)(lds + G_SA(b, h) + aoff + m * 2048 + k * 1024); } while (0)
#define G_LDB(dst, b, h) do { _Pragma("unroll") for (int n = 0; n < 2; ++n) _Pragma("unroll") for (int k = 0; k < 2; ++k) dst[n][k] = *(const LAS bf16x8*)(lds + G_SB(b, h) + boff + n * 2048 + k * 1024); } while (0)
#define G_MMA(ai, bj, At, Bt) do { __builtin_amdgcn_s_setprio(1); _Pragma("unroll") for (int m = 0; m < 4; ++m) _Pragma("unroll") for (int n = 0; n < 2; ++n) _Pragma("unroll") for (int k = 0; k < 2; ++k) \
        acc[ai][bj][m][n] = __builtin_amdgcn_mfma_f32_16x16x32_bf16(Bt[n][k], At[m][k], acc[ai][bj][m][n], 0, 0, 0); __builtin_amdgcn_s_setprio(0); } while (0)
#define G_WAIT_V(n) asm volatile("s_waitcnt vmcnt(" #n ")" ::: "memory")
#define G_WAIT_L(n) asm volatile("s_waitcnt lgkmcnt(" #n ")" ::: "memory")
#define G_BAR __builtin_amdgcn_s_barrier()
#define G_SCHED __builtin_amdgcn_sched_barrier(0)
    Unit cur, nxt; int ui = 0;
    if (!next_unit(descs, nd, 0, cur)) return;
    GDesc cd = load_desc(descs + cur.d, wsb);
    UP c, n2; unit_setup(c, cd, cur);
    int nt = cd.nt;
    f32x4 acc[2][2][4][2];
#pragma unroll
    for (int a = 0; a < 2; ++a)
#pragma unroll
        for (int b = 0; b < 2; ++b)
#pragma unroll
            for (int m = 0; m < 4; ++m)
#pragma unroll
                for (int n = 0; n < 2; ++n) acc[a][b][m][n] = (f32x4){0.f, 0.f, 0.f, 0.f};
    bf16x8 At[4][2], B0[2][2], B1[2][2];
    G_STAGE_B(G_SB(0, 0), c.B, c); G_STAGE_A(G_SA(0, 0), c.A, c); G_STAGE_B(G_SB(0, 1), c.B + c.hB, c); G_STAGE_A(G_SA(0, 1), c.A + c.hA, c);
    if (wr == 1) G_BAR;
    G_WAIT_V(4); G_BAR;
    G_STAGE_B(G_SB(1, 0), c.B + kstep, c); G_STAGE_A(G_SA(1, 0), c.A + kstep, c); G_STAGE_B(G_SB(1, 1), c.B + c.hB + kstep, c);
    G_WAIT_V(6); G_BAR;
    for (;;) {
        const bool has_next = next_unit(descs, nd, ui + 1, nxt);
        GDesc ndsc = cd;
        if (has_next) { ndsc = load_desc(descs + nxt.d, wsb); unit_setup(n2, ndsc, nxt); } else { n2 = c; }
        for (int t = 0; t < nt; t += 2) {
            const bool last = (t == nt - 2);
            const char* a1 = c.A + (size_t)(t + 1) * kstep;
            UP x = c; if (last) x = n2;
            const char* a2 = last ? n2.A : c.A + (size_t)(t + 2) * kstep; const char* b2 = last ? n2.B : c.B + (size_t)(t + 2) * kstep;
            const char* a3 = a2 + kstep; const char* b3 = b2 + kstep;
            G_LDB(B0, 0, 0); G_SCHED; G_LDA(At, 0, 0); G_STAGE_A(G_SA(1, 1), a1 + c.hA, c);
            G_WAIT_L(8); G_BAR; G_WAIT_L(0); G_MMA(0, 0, At, B0); G_BAR; G_SCHED;
            G_LDB(B1, 0, 1); G_STAGE_B(G_SB(0, 0), b2, x);
            G_BAR; G_WAIT_L(0); G_MMA(0, 1, At, B1); G_BAR;
            G_LDA(At, 0, 1); G_STAGE_A(G_SA(0, 0), a2, x);
            G_BAR; G_WAIT_L(0); G_MMA(1, 0, At, B0); G_BAR; G_SCHED;
            G_STAGE_B(G_SB(0, 1), b2 + x.hB, x);
            G_WAIT_V(6); G_BAR; G_MMA(1, 1, At, B1); G_BAR;
            G_LDB(B0, 1, 0); G_SCHED; G_LDA(At, 1, 0); G_STAGE_A(G_SA(0, 1), a2 + x.hA, x);
            G_WAIT_L(8); G_BAR; G_WAIT_L(0); G_MMA(0, 0, At, B0); G_BAR; G_SCHED;
            G_LDB(B1, 1, 1); G_STAGE_B(G_SB(1, 0), b3, x);
            G_BAR; G_WAIT_L(0); G_MMA(0, 1, At, B1); G_BAR;
            G_LDA(At, 1, 1); G_STAGE_A(G_SA(1, 0), a3, x);
            G_BAR; G_WAIT_L(0); G_MMA(1, 0, At, B0); G_BAR; G_SCHED;
            G_STAGE_B(G_SB(1, 1), b3 + x.hB, x);
            G_WAIT_V(6); G_BAR; G_MMA(1, 1, At, B1); G_BAR;
        }
        gemm_epilogue(acc, cd, cur, wr, wc, fr, fq, lp_);
        if (!has_next) break;
#pragma unroll
        for (int a = 0; a < 2; ++a)
#pragma unroll
            for (int b = 0; b < 2; ++b)
#pragma unroll
                for (int m = 0; m < 4; ++m)
#pragma unroll
                    for (int n = 0; n < 2; ++n) acc[a][b][m][n] = (f32x4){0.f, 0.f, 0.f, 0.f};
        cur = nxt; cd = ndsc; c = n2; nt = cd.nt; ++ui;
    }
    G_WAIT_V(0);
    if (wr == 0) G_BAR;
    G_BAR;
}

__device__ __forceinline__ void tr_job(float* tile, const float* src, int K, int Nsrc, int Ndst, bf16_t* dst, int ldd, int koff, int half, int rowoff, int bid, int nb) {
    const int tid = otid(); const int tk = K / 64, tn = (Ndst + 255) / 256, nt = tk * tn;
    const int kr = tid >> 6, n4 = (tid & 63) * 4;
    f32x4 v[8];
#define TR_LOAD(tt) do { const int kt_ = (tt) / tn, nt_ = (tt) % tn; const bool ok_ = (nt_ * 256 + n4) < Nsrc; \
        const float* sp_ = src + (size_t)(kt_ * 64 + kr) * Nsrc + (ok_ ? nt_ * 256 + n4 : 0); \
        _Pragma("unroll") for (int i = 0; i < 8; ++i) v[i] = *(const f32x4*)(sp_ + (size_t)(8 * i) * Nsrc); } while (0)
    if (bid < nt) TR_LOAD(bid);
    for (int t = bid; t < nt; t += nb) {
        const int kt = t / tn, ntile = t % tn, k0 = kt * 64, n0 = ntile * 256;
        const bool ok = (n0 + n4) < Nsrc;
        __syncthreads();
#pragma unroll
        for (int i = 0; i < 8; ++i) *(f32x4*)(tile + (kr + 8 * i) * 260 + n4) = ok ? v[i] : (f32x4){0.f, 0.f, 0.f, 0.f};
        __syncthreads();
        if (t + nb < nt) TR_LOAD(t + nb);
        const int n = tid >> 1, kh = (tid & 1) * 32, gn = n0 + n;
        if (gn < Ndst) {
            float o[32];
#pragma unroll
            for (int j = 0; j < 32; ++j) o[j] = tile[(kh + j) * 260 + n];
            int drow = gn;
            if (half) drow = gn < half ? (gn / 128) * 256 + (gn % 128) : ((gn - half) / 128) * 256 + 128 + ((gn - half) % 128);
            bf16_t* dp = dst + (size_t)(rowoff + drow) * ldd + koff + k0 + kh;
#pragma unroll
            for (int j = 0; j < 4; ++j) *(bf16x8*)(dp + j * 8) = pack8(o + j * 8);
        }
    }
#undef TR_LOAD
}

__device__ __forceinline__ float sumsq4(const f32x4 (&v)[4]) {
    float ss = 0.f;
#pragma unroll
    for (int i = 0; i < 4; ++i) ss += v[i][0] * v[i][0] + v[i][1] * v[i][1] + v[i][2] * v[i][2] + v[i][3] * v[i][3];
    return ss;
}
__device__ __forceinline__ void ph_rowpass(float* X, const float* Y, float scale, const float* ga, const float* gb, bf16_t* XN, bool has_gb) {
    const int tid_ = otid(); const int wid = tid_ >> 6, lane = tid_ & 63;
    f32x4 gav[4], gbv[4];
#pragma unroll
    for (int i = 0; i < 4; ++i) { gav[i] = *(const f32x4*)(ga + i * 256 + lane * 4); gbv[i] = *(const f32x4*)(gb + i * 256 + lane * 4); }
    f32x4 nx[4], ny[4];
    int row = blockIdx.x * 8 + wid;
#pragma unroll
    for (int i = 0; i < 4; ++i) { nx[i] = *(const f32x4*)(X + (size_t)row * 1024 + i * 256 + lane * 4); ny[i] = *(const f32x4*)(Y + (size_t)row * 1024 + i * 256 + lane * 4); }
    for (; row < M; row += gridDim.x * 8) {
        f32x4 xv[4], yv[4];
#pragma unroll
        for (int i = 0; i < 4; ++i) { xv[i] = nx[i]; yv[i] = ny[i]; }
        const int nrow = row + gridDim.x * 8;
        if (nrow < M) {
#pragma unroll
            for (int i = 0; i < 4; ++i) { nx[i] = *(const f32x4*)(X + (size_t)nrow * 1024 + i * 256 + lane * 4); ny[i] = *(const f32x4*)(Y + (size_t)nrow * 1024 + i * 256 + lane * 4); }
        }
        const float inv = rsqrtf(wave_sum(sumsq4(yv)) * (1.f / 1024.f) + 1e-6f) * scale;
#pragma unroll
        for (int i = 0; i < 4; ++i) { xv[i] += yv[i] * inv * gav[i]; *(f32x4*)(X + (size_t)row * 1024 + i * 256 + lane * 4) = xv[i]; }
        if (has_gb) {
            const float inv2 = rsqrtf(wave_sum(sumsq4(xv)) * (1.f / 1024.f) + 1e-6f);
#pragma unroll
            for (int i = 0; i < 4; ++i) { const f32x4 o = xv[i] * inv2 * gbv[i];
                const u32x2 pk = {cvt_pk_bf16(o[0], o[1]), cvt_pk_bf16(o[2], o[3])}; *(u32x2*)(XN + (size_t)row * 1024 + i * 256 + lane * 4) = pk; }
        }
    }
}
__device__ __forceinline__ void ph_firstnorm(const float* xin, float* X, const float* gb, bf16_t* XN) {
    const int tid_ = otid(); const int wid = tid_ >> 6, lane = tid_ & 63;
    for (int row = blockIdx.x * 8 + wid; row < M; row += gridDim.x * 8) {
        f32x4 xv[4];
#pragma unroll
        for (int i = 0; i < 4; ++i) { xv[i] = *(const f32x4*)(xin + (size_t)row * 1024 + i * 256 + lane * 4); *(f32x4*)(X + (size_t)row * 1024 + i * 256 + lane * 4) = xv[i]; }
        const float inv2 = rsqrtf(wave_sum(sumsq4(xv)) * (1.f / 1024.f) + 1e-6f);
#pragma unroll
        for (int i = 0; i < 4; ++i) { const f32x4 g = *(const f32x4*)(gb + i * 256 + lane * 4); const f32x4 o = xv[i] * inv2 * g;
            const u32x2 pk = {cvt_pk_bf16(o[0], o[1]), cvt_pk_bf16(o[2], o[3])}; *(u32x2*)(XN + (size_t)row * 1024 + i * 256 + lane * 4) = pk; }
    }
}

__device__ __forceinline__ void ph_gdn_prep(unsigned char* shm, const Params* lp_) {
    float* qs = (float*)shm; float* ks = qs + 64 * 132; float* vs = ks + 64 * 132; float* Ls = vs + 64 * 132; float* beta = Ls + 64 * 68; float* gc = beta + 64; float* eg = gc + 64;
    const int tid = otid(), wid = tid >> 6, lane = tid & 63;
    const bf16_t* PROJ = (const bf16_t*)(rflp(lp_->ws) + G_PROJ); const float* BA = (const float*)(rflp(lp_->ws) + G_BA);
    float* U = (float*)(rflp(lp_->ws) + OFF_Y); bf16_t* Wb = (bf16_t*)(rflp(lp_->ws) + G_WB); bf16_t* QD = (bf16_t*)(rflp(lp_->ws) + G_QD); bf16_t* QK = (bf16_t*)(rflp(lp_->ws) + G_QK); bf16_t* KDT = (bf16_t*)(rflp(lp_->ws) + G_KDT); float* GL = (float*)(rflp(lp_->ws) + G_GL);
    const float* convw = rflp(lp_->in[5]); const float* a_log = rflp(lp_->in[6]); const float* dtb = rflp(lp_->in[7]);
    const int hfix = blockIdx.x & 7;
    const int cq = tid % 96, rg = tid / 96, seg = cq >> 5, col = (cq & 31) * 4; const int ch = seg * 1024 + hfix * 128 + col; const int r0 = rg * 13;
    u32x2 xw[16]; f32x4 cw[4]; float nbb = 0.f, naa = 0.f;
#pragma unroll
    for (int j = 0; j < 4; ++j) cw[j] = (tid < 480) ? *(const f32x4*)(convw + j * 3072 + ch) : (f32x4){0.f, 0.f, 0.f, 0.f};
    const float alh = -__expf(a_log[hfix]), dth = dtb[hfix];
#define GP_LOAD(tk_) do { const int n_ = ((tk_) >> 3) & 63, b_ = (tk_) >> 9; const int t0_ = n_ * 64; \
        if (tid < 480) { _Pragma("unroll") for (int i = 0; i < 16; ++i) { const int tt = t0_ + r0 - 3 + i; const int rl = r0 - 3 + i; xw[i] = (u32x2){0u, 0u}; \
            if (tt >= 0 && rl < 64) xw[i] = *(const u32x2*)(PROJ + ((size_t)b_ * T + tt) * 4352 + ch); } } \
        if (tid < 64) { nbb = BA[((size_t)b_ * T + t0_ + tid) * 16 + hfix]; naa = BA[((size_t)b_ * T + t0_ + tid) * 16 + 8 + hfix]; } } while (0)
    if ((int)blockIdx.x < 2048) GP_LOAD(blockIdx.x);
    for (int task = blockIdx.x; task < 2048; task += gridDim.x) {
        const int h = hfix, n = (task >> 3) & 63, b = task >> 9; const int t0 = n * 64; const size_t rowb = (size_t)b * T + t0;
        (void)rowb; (void)t0;
        LDS_BARRIER();
        if (tid < 480) {
            float* dst = (seg == 0 ? qs : (seg == 1 ? ks : vs));
#pragma unroll
            for (int i = 0; i < 13; ++i) { if (r0 + i < 64) { f32x4 a = {0.f, 0.f, 0.f, 0.f};
#pragma unroll
                for (int j = 0; j < 4; ++j) { const u32x2 xv = xw[i + j]; a[0] += cw[j][0] * lo_bf(xv[0]); a[1] += cw[j][1] * hi_bf(xv[0]); a[2] += cw[j][2] * lo_bf(xv[1]); a[3] += cw[j][3] * hi_bf(xv[1]); }
#pragma unroll
                for (int j = 0; j < 4; ++j) a[j] = siluf_(a[j]);
                *(f32x4*)(dst + (r0 + i) * 132 + col) = a; } }
        }
        if (tid < 64) {
            beta[tid] = sigmoidf_(nbb);
            float g = alh * softplusf_(naa + dth);
#pragma unroll
            for (int o = 1; o < 64; o <<= 1) { const float t = __shfl_up(g, o, 64); if (lane >= o) g += t; }
            gc[tid] = g; eg[tid] = __expf(g);
        }
        if (task + (int)gridDim.x < 2048) GP_LOAD(task + gridDim.x);
        LDS_BARRIER();
        for (int rr = wid; rr < 128; rr += 8) {
            float* arr = rr < 64 ? qs : ks; const int r = rr & 63; const float x0 = arr[r * 132 + lane], x1 = arr[r * 132 + 64 + lane];
            const float ss = wave_sum(x0 * x0 + x1 * x1); const float sc = rsqrtf(ss + 1e-6f) * (rr < 64 ? 0.08838834764831845f : 1.f);
            arr[r * 132 + lane] = x0 * sc; arr[r * 132 + 64 + lane] = x1 * sc;
        }
        LDS_BARRIER();
        for (int jj = 0; jj < 4; ++jj) {
            const int job = wid * 4 + jj, mat = job >> 4, tile = job & 15, ti = tile >> 2, tj = tile & 3;
            const float* Am = mat ? qs : ks;
            f32x4 acc = {0.f, 0.f, 0.f, 0.f};
            if (tj <= ti) {
#pragma unroll
                for (int kk = 0; kk < 4; ++kk) {
                    const float* ap = Am + (ti * 16 + (lane & 15)) * 132 + kk * 32 + (lane >> 4) * 8; const float* bp = ks + (tj * 16 + (lane & 15)) * 132 + kk * 32 + (lane >> 4) * 8;
                    const bf16x8 af = pack8v(*(const f32x4*)ap, *(const f32x4*)(ap + 4)), bf = pack8v(*(const f32x4*)bp, *(const f32x4*)(bp + 4));
                    acc = MFMA16(af, bf, acc);
                }
            }
            const int s = tj * 16 + (lane & 15);
#pragma unroll
            for (int j = 0; j < 4; ++j) { const int cc = ti * 16 + (lane >> 4) * 4 + j;
                if (mat == 0) { Ls[s * 68 + cc] = (cc > s) ? acc[j] * __expf(gc[cc] - gc[s]) * beta[cc] : 0.f; }
                else { QK[(size_t)task * 4096 + ((((cc >> 4) * 2 + (s >> 5)) * 64 + ((s >> 3) & 3) * 16 + (cc & 15)) << 3) + (s & 7)] = f2bf((cc >= s) ? acc[j] * __expf(gc[cc] - gc[s]) : 0.f); } }
        }
        LDS_BARRIER();
        {
#pragma unroll
            for (int i = 0; i < 2; ++i) { const int v = tid + 512 * i, cr = v >> 4, d8 = (v & 15) * 8; const float e = eg[cr]; float o[8];
#pragma unroll
                for (int j = 0; j < 8; ++j) o[j] = qs[cr * 132 + d8 + j] * e;
                *(bf16x8*)(QD + (size_t)task * 8192 + ((((cr >> 4) * 4 + (d8 >> 5)) * 64 + ((d8 >> 3) & 3) * 16 + (cr & 15)) << 3)) = pack8(o); }
            const float glast = gc[63];
#pragma unroll
            for (int i = 0; i < 2; ++i) { const int v = tid + 512 * i, dd = v >> 3, c8 = (v & 7) * 8; float o[8];
#pragma unroll
                for (int j = 0; j < 8; ++j) o[j] = ks[(c8 + j) * 132 + dd] * __expf(glast - gc[c8 + j]);
                *(bf16x8*)(KDT + (size_t)task * 8192 + ((((dd >> 4) * 2 + (c8 >> 5)) * 64 + ((c8 >> 3) & 3) * 16 + (dd & 15)) << 3)) = pack8(o); }
            if (tid == 0) GL[task] = eg[63];
        }
        LDS_BARRIER();
        if (tid < 256) {
            const int col = tid; const bool isu = col < 128; float* src = isu ? vs : ks; const int cc = isu ? col : col - 128;
#pragma unroll 1
            for (int rb = 0; rb < 4; ++rb) {
                float a[16];
#pragma unroll
                for (int i = 0; i < 16; ++i) { const int ci = rb * 16 + i; a[i] = src[ci * 132 + cc] * beta[ci] * (isu ? 1.f : eg[ci]); }
#pragma unroll 1
                for (int sx = 0; sx < rb * 16; ++sx) { const float sv = src[sx * 132 + cc];
#pragma unroll
                    for (int i4 = 0; i4 < 4; ++i4) { const f32x4 l = *(const f32x4*)(Ls + sx * 68 + rb * 16 + i4 * 4);
                        a[i4 * 4] -= l[0] * sv; a[i4 * 4 + 1] -= l[1] * sv; a[i4 * 4 + 2] -= l[2] * sv; a[i4 * 4 + 3] -= l[3] * sv; } }
#pragma unroll
                for (int i2 = 0; i2 < 16; ++i2) { const float sv = a[i2]; const int ci = rb * 16 + i2;
                    src[ci * 132 + cc] = sv;
                    if (isu) U[((size_t)task * 64 + ci) * 128 + cc] = sv; else Wb[(size_t)task * 8192 + ((((ci >> 4) * 4 + (cc >> 5)) * 64 + ((cc >> 3) & 3) * 16 + (ci & 15)) << 3) + (cc & 7)] = f2bf(sv);
#pragma unroll
                    for (int i4 = 0; i4 < 4; ++i4) { if (i4 * 4 + 3 > i2) { const f32x4 l = *(const f32x4*)(Ls + ci * 68 + rb * 16 + i4 * 4);
#pragma unroll
                        for (int j = 0; j < 4; ++j) if (i4 * 4 + j > i2) a[i4 * 4 + j] -= l[j] * sv; } } }
            }
        }
    }
}

#undef GP_LOAD
struct GdnOps { bf16x8 Aw[4], Aq[4], Aqk[2], Akd[2][2]; float u4[4]; float gl; };
__device__ __forceinline__ void ph_gdn_scan(unsigned char* shm, const Params* lp_) {
    const int tid = otid(), wid = tid >> 6, lane = tid & 63, grp = wid >> 2, mw = wid & 3, l15 = lane & 15, lq = lane >> 4;
    bf16_t* SBT = (bf16_t*)shm + grp * (16 * 136 + 16 * 72); bf16_t* VBT = SBT + 16 * 136;
    const int xw_ = blockIdx.x & 7, xi_ = blockIdx.x >> 3; const int ch = (xw_ * 4 + (xi_ >> 2)) * 8 + (xi_ & 3) * 2 + grp; const int sl = ch & 7, h = (ch >> 3) & 7, b = ch >> 6;
    const float* U = (const float*)(rflp(lp_->ws) + OFF_Y); const bf16_t* Wb = (const bf16_t*)(rflp(lp_->ws) + G_WB); const bf16_t* QD = (const bf16_t*)(rflp(lp_->ws) + G_QD); const bf16_t* QK = (const bf16_t*)(rflp(lp_->ws) + G_QK); const bf16_t* KDT = (const bf16_t*)(rflp(lp_->ws) + G_KDT); const float* GL = (const float*)(rflp(lp_->ws) + G_GL);
    float* O = (float*)(rflp(lp_->ws) + OFF_H);
    f32x4 S0 = {0.f, 0.f, 0.f, 0.f}, S1 = {0.f, 0.f, 0.f, 0.f};
#define GDN_LOAD(R, nn) do { const size_t task_ = ((size_t)b * 64 + (nn)) * 8 + h; \
        _Pragma("unroll") for (int k = 0; k < 4; ++k) { R.Aw[k] = *(const bf16x8*)(Wb + task_ * 8192 + (((mw * 4 + k) * 64 + lane) << 3)); R.Aq[k] = *(const bf16x8*)(QD + task_ * 8192 + (((mw * 4 + k) * 64 + lane) << 3)); } \
        _Pragma("unroll") for (int k = 0; k < 2; ++k) R.Aqk[k] = *(const bf16x8*)(QK + task_ * 4096 + (((mw * 2 + k) * 64 + lane) << 3)); \
        _Pragma("unroll") for (int i = 0; i < 2; ++i) _Pragma("unroll") for (int k = 0; k < 2; ++k) R.Akd[i][k] = *(const bf16x8*)(KDT + task_ * 8192 + ((((2 * mw + i) * 2 + k) * 64 + lane) << 3)); \
        _Pragma("unroll") for (int j = 0; j < 4; ++j) R.u4[j] = U[(task_ * 64 + 16 * mw + lq * 4 + j) * 128 + sl * 16 + l15]; \
        R.gl = GL[task_]; } while (0)
#define GDN_STEP(R, nn) do { \
        { const u32x2 w0 = {cvt_pk_bf16(S0[0], S0[1]), cvt_pk_bf16(S0[2], S0[3])}, w1 = {cvt_pk_bf16(S1[0], S1[1]), cvt_pk_bf16(S1[2], S1[3])}; \
          *(u32x2*)(SBT + l15 * 136 + 32 * mw + lq * 4) = w0; *(u32x2*)(SBT + l15 * 136 + 32 * mw + 16 + lq * 4) = w1; } \
        LDS_BARRIER(); \
        f32x4 P = {0.f, 0.f, 0.f, 0.f}, O1 = {0.f, 0.f, 0.f, 0.f}; \
        _Pragma("unroll") for (int k = 0; k < 4; ++k) { const bf16x8 sb = *(const bf16x8*)(SBT + l15 * 136 + k * 32 + lq * 8); P = MFMA16(R.Aw[k], sb, P); O1 = MFMA16(R.Aq[k], sb, O1); } \
        const f32x4 vn = {R.u4[0] - P[0], R.u4[1] - P[1], R.u4[2] - P[2], R.u4[3] - P[3]}; \
        { const u32x2 w = {cvt_pk_bf16(vn[0], vn[1]), cvt_pk_bf16(vn[2], vn[3])}; *(u32x2*)(VBT + l15 * 72 + 16 * mw + lq * 4) = w; } \
        LDS_BARRIER(); \
        bf16x8 Vb[2]; \
        _Pragma("unroll") for (int k = 0; k < 2; ++k) Vb[k] = *(const bf16x8*)(VBT + l15 * 72 + k * 32 + lq * 8); \
        _Pragma("unroll") for (int k = 0; k < 2; ++k) O1 = MFMA16(R.Aqk[k], Vb[k], O1); \
        _Pragma("unroll") for (int j = 0; j < 4; ++j) O[((size_t)b * T + (nn) * 64 + 16 * mw + lq * 4 + j) * 1024 + h * 128 + sl * 16 + l15] = O1[j]; \
        S0 *= R.gl; S1 *= R.gl; \
        _Pragma("unroll") for (int k = 0; k < 2; ++k) { S0 = MFMA16(R.Akd[0][k], Vb[k], S0); S1 = MFMA16(R.Akd[1][k], Vb[k], S1); } } while (0)
    GdnOps RA, RB;
    GDN_LOAD(RA, 0); GDN_LOAD(RB, 1);
    for (int n = 0; n < 64; n += 2) {
        GDN_STEP(RA, n);
        if (n + 2 < 64) GDN_LOAD(RA, n + 2);
        GDN_STEP(RB, n + 1);
        if (n + 3 < 64) GDN_LOAD(RB, n + 3);
    }
#undef GDN_LOAD
#undef GDN_STEP
}

__device__ __forceinline__ void ph_gdn_gate(const Params* lp_) {
    const int tid_ = otid(); const int wid = tid_ >> 6, lane = tid_ & 63; const int hh = lane >> 3, sub = lane & 7;
    const float* O = (const float*)(rflp(lp_->ws) + OFF_H); const bf16_t* PROJ = (const bf16_t*)(rflp(lp_->ws) + G_PROJ); bf16_t* OG = (bf16_t*)(rflp(lp_->ws) + OFF_XN); const float* nw = rflp(lp_->in[8]);
    f32x4 nwv[4];
#pragma unroll
    for (int i = 0; i < 4; ++i) nwv[i] = *(const f32x4*)(nw + sub * 16 + i * 4);
    const int col = hh * 128 + sub * 16;
    f32x4 no[4]; u32x4 nz0, nz1; int row = blockIdx.x * 8 + wid;
#define GG_LOAD(rr_) do { _Pragma("unroll") for (int i = 0; i < 4; ++i) no[i] = *(const f32x4*)(O + (size_t)(rr_) * 1024 + col + i * 4); \
        nz0 = *(const u32x4*)(PROJ + (size_t)(rr_) * 4352 + 3072 + col); nz1 = *(const u32x4*)(PROJ + (size_t)(rr_) * 4352 + 3072 + col + 8); } while (0)
    GG_LOAD(row);
    for (; row < M; row += gridDim.x * 8) {
        f32x4 o[4]; float ss = 0.f; const u32x4 z0 = nz0, z1 = nz1;
#pragma unroll
        for (int i = 0; i < 4; ++i) { o[i] = no[i]; ss += o[i][0] * o[i][0] + o[i][1] * o[i][1] + o[i][2] * o[i][2] + o[i][3] * o[i][3]; }
        if (row + (int)gridDim.x * 8 < M) GG_LOAD(row + gridDim.x * 8);
        ss += __shfl_xor(ss, 1, 64); ss += __shfl_xor(ss, 2, 64); ss += __shfl_xor(ss, 4, 64);
        const float inv = rsqrtf(ss * (1.f / 128.f) + 1e-6f);
        float v[16];
#pragma unroll
        for (int i = 0; i < 4; ++i) { const f32x4 w = nwv[i];
#pragma unroll
            for (int j = 0; j < 4; ++j) v[i * 4 + j] = o[i][j] * inv * w[j]; }
#pragma unroll
        for (int i = 0; i < 4; ++i) { v[2 * i] *= siluf_(lo_bf(z0[i])); v[2 * i + 1] *= siluf_(hi_bf(z0[i])); v[8 + 2 * i] *= siluf_(lo_bf(z1[i])); v[8 + 2 * i + 1] *= siluf_(hi_bf(z1[i])); }
        *(bf16x8*)(OG + (size_t)row * 1024 + col) = pack8(v); *(bf16x8*)(OG + (size_t)row * 1024 + col + 8) = pack8(v + 8);
    }
#undef GG_LOAD
}

__device__ __forceinline__ void ph_rwkv_mix(const Params* lp_) {
    const bf16_t* XN = (const bf16_t*)(rflp(lp_->ws) + OFF_XN); bf16_t* XM = (bf16_t*)(rflp(lp_->ws) + R_XM); const float* mu = rflp(lp_->in[10]);
    const int v0_ = blockIdx.x * 512 + otid(); const int cfix = (v0_ & 127) * 8;
    f32x4 muv[6][2];
#pragma unroll
    for (int i = 0; i < 6; ++i) { muv[i][0] = *(const f32x4*)(mu + i * 1024 + cfix); muv[i][1] = *(const f32x4*)(mu + i * 1024 + cfix + 4); }
    const int c = cfix; u32x4 nxc, nxp; int v = v0_;
#define MIX_LOAD(vv_) do { const int r_ = (vv_) >> 7; const int rp_ = (r_ & (T - 1)) > 0 ? r_ - 1 : r_; nxc = *(const u32x4*)(XN + (size_t)r_ * 1024 + c); nxp = *(const u32x4*)(XN + (size_t)rp_ * 1024 + c); } while (0)
    MIX_LOAD(v);
    for (; v < M * 128; v += gridDim.x * 512) {
        const int row = v >> 7; const int t = row & (T - 1);
        const u32x4 xc = nxc; u32x4 xp = nxp; if (t == 0) xp = (u32x4){0u, 0u, 0u, 0u};
        if (v + (int)gridDim.x * 512 < M * 128) MIX_LOAD(v + gridDim.x * 512);
        float x[8], dx[8];
#pragma unroll
        for (int i = 0; i < 4; ++i) { x[2 * i] = lo_bf(xc[i]); x[2 * i + 1] = hi_bf(xc[i]); dx[2 * i] = lo_bf(xp[i]) - x[2 * i]; dx[2 * i + 1] = hi_bf(xp[i]) - x[2 * i + 1]; }
#pragma unroll
        for (int i = 0; i < 6; ++i) { const f32x4 m0 = muv[i][0], m1 = muv[i][1]; float o[8];
#pragma unroll
            for (int j = 0; j < 4; ++j) { o[j] = x[j] + dx[j] * m0[j]; o[4 + j] = x[4 + j] + dx[4 + j] * m1[j]; }
            *(bf16x8*)(XM + (size_t)row * 6144 + i * 1024 + c) = pack8(o); }
    }
#undef MIX_LOAD
}

constexpr int WT2_TOTAL = 4 * (2816 + 1408) + 2688 + 1024 + 1024 + 4 * 64 + 512;
struct WTile { const float* sp; bf16_t* dp; int ok; };
__device__ __forceinline__ WTile wtile_decode(const Params* lp_, int ti, int lane) {
    unsigned char* ws = rflp(lp_->ws);
    const float* src; int K, Ns, Nd, ldd, half = 0; bf16_t* dst; int j2 = 0, t = ti;
    for (; j2 < 16; ++j2) {
        const int cnt = j2 < 8 ? ((j2 & 1) ? 1408 : 2816) : (j2 == 8 ? 2688 : (j2 == 9 ? 1024 : (j2 == 10 ? 1024 : (j2 < 15 ? 64 : 512))));
        if (t < cnt) break; t -= cnt;
    }
    if (j2 < 8) { const int i = 4 + (j2 >> 1);
        if ((j2 & 1) == 0) { src = rflp(lp_->in[2]) + (size_t)i * 1024 * 5632; K = 1024; Ns = 5632; Nd = 5632; dst = (bf16_t*)(ws + OFF_WF_IN + i * SZ_WF_IN1); ldd = 1024; half = 2816; }
        else { src = rflp(lp_->in[3]) + (size_t)i * 2816 * 1024; K = 2816; Ns = 1024; Nd = 1024; dst = (bf16_t*)(ws + OFF_WF_OUT + i * SZ_WF_OUT1); ldd = 2816; } }
    else if (j2 == 8) { src = rflp(lp_->in[26]); K = 1024; Ns = 5152; Nd = 5376; dst = (bf16_t*)(ws + OFF_W_SSD_IN); ldd = 1024; }
    else if (j2 == 9) { src = rflp(lp_->in[33]); K = 2048; Ns = 1024; Nd = 1024; dst = (bf16_t*)(ws + OFF_W_SSD_OUT); ldd = 2048; }
    else if (j2 == 10) { src = rflp(lp_->in[34]); K = 1024; Ns = 2048; Nd = 2048; dst = (bf16_t*)(ws + OFF_W_LRU_IN); ldd = 1024; }
    else if (j2 < 15) { src = rflp(lp_->in[37]) + (size_t)(j2 - 11) * 256 * 512; K = 256; Ns = 512; Nd = 512; dst = (bf16_t*)(ws + OFF_W_LRU_G) + (size_t)(j2 - 11) * 512 * 256; ldd = 256; half = 256; }
    else { src = rflp(lp_->in[40]); K = 1024; Ns = 1024; Nd = 1024; dst = (bf16_t*)(ws + OFF_W_LRU_OUT); ldd = 1024; }
    (void)K;
    const int tn = Nd / 64, kt = t / tn, ntile = t % tn, k0 = kt * 32, gn = ntile * 64 + lane;
    int drow = gn;
    if (half) drow = gn < half ? (gn / 128) * 256 + (gn % 128) : ((gn - half) / 128) * 256 + 128 + ((gn - half) % 128);
    WTile w; w.ok = gn < Ns; w.sp = src + (size_t)k0 * Ns + (w.ok ? gn : 0); w.dp = dst + (size_t)drow * ldd + k0;
    w.ok |= (Ns << 1);
    return w;
}

constexpr int RW_TC = 32, RW_STRIDE = 392;
__device__ __forceinline__ void ph_rwkv_scan(unsigned char* shm, const Params* lp_) {
    float* buf = (float*)shm;
    const int tid = otid(), wid = tid >> 6, lane = tid & 63;
    const float* Rr = (const float*)(rflp(lp_->ws) + OFF_Y); const float* Kk = (const float*)(rflp(lp_->ws) + R_K); const float* Vv = (const float*)(rflp(lp_->ws) + R_V);
    const float* Wd = (const float*)(rflp(lp_->ws) + R_XM); const float* Aa = Wd + MS * 1024;
    float* YS = (float*)(rflp(lp_->ws) + OFF_H);
    const float* k_k = rflp(lp_->in[20]); const float* k_a = rflp(lp_->in[21]); const float* r_k = rflp(lp_->in[22]); float* RKB = (float*)(rflp(lp_->ws) + R_LOR);
    for (int item0 = blockIdx.x; item0 < 256; item0 += gridDim.x) {
        const int item = ((item0 & 7) * 8 + (item0 >> 5)) * 4 + ((item0 >> 3) & 3);
        const int q = item & 3, h = (item >> 2) & 15, b = item >> 6;
        __syncthreads();
        if (wid >= 4) {
            const int lw = wid - 4, rr = lane >> 4, seg = lane & 15, c = h * 64 + seg * 4;
            const f32x4 kkc = *(const f32x4*)(k_k + c), kac = *(const f32x4*)(k_a + c), rkc = *(const f32x4*)(r_k + c);
            f32x4 r[2], k[2], v[2], w[2], a[2];
#pragma unroll
            for (int ps = 0; ps < 2; ++ps) { const size_t idx = ((size_t)b * T + lw * 8 + ps * 4 + rr) * 1024 + c;
                r[ps] = *(const f32x4*)(Rr + idx); k[ps] = *(const f32x4*)(Kk + idx); v[ps] = *(const f32x4*)(Vv + idx); w[ps] = *(const f32x4*)(Wd + idx); a[ps] = *(const f32x4*)(Aa + idx); }
            float cv[32]; bf16_t* cdp = nullptr; int cok = 0;
            const int gw = blockIdx.x * 4 + lw;
            for (int ci = -1; ci < T / RW_TC - 1; ++ci) {
                if ((ci & 3) == 0) {
                    if (cdp != nullptr) {
                        if (!(cok & 1)) {
#pragma unroll
                            for (int j = 0; j < 32; ++j) cv[j] = 0.f; }
#pragma unroll
                        for (int j = 0; j < 4; ++j) *(bf16x8*)(cdp + j * 8) = pack8(cv + j * 8);
                        cdp = nullptr;
                    }
                    const int ti = gw + 1024 * (ci >> 2);
                    if (ti < WT2_TOTAL) {
                        const WTile wt = wtile_decode(lp_, ti, lane); cdp = wt.dp; cok = wt.ok; const int nsrc = wt.ok >> 1;
#pragma unroll
                        for (int j = 0; j < 32; ++j) cv[j] = wt.sp[(size_t)j * nsrc];
                    }
                }
                float* bb = buf + ((ci + 1) & 1) * (RW_TC * RW_STRIDE);
#pragma unroll
                for (int ps = 0; ps < 2; ++ps) {
                    const f32x4 kkr = k[ps] * kkc; const float n2 = dpp_sum16(kkr[0] * kkr[0] + kkr[1] * kkr[1] + kkr[2] * kkr[2] + kkr[3] * kkr[3]);
                    const f32x4 kk = kkr * rsqrtf(n2 + 1e-6f); const f32x4 kp = k[ps] * (1.f + (a[ps] - 1.f) * kac); const f32x4 bt = kk * a[ps];
                    const f32x4 t1 = bt * r[ps], t2 = kp * r[ps];
                    const float br = dpp_sum16(t1[0] + t1[1] + t1[2] + t1[3]), kr = dpp_sum16(t2[0] + t2[1] + t2[2] + t2[3]);
                    const f32x4 t3 = t2 * rkc; const float rkv = dpp_sum16(t3[0] + t3[1] + t3[2] + t3[3]);
                    if (q == 0 && seg == 0) RKB[((size_t)b * T + (ci + 1) * RW_TC + lw * 8 + ps * 4 + rr) * 16 + h] = rkv;
                    float* o = bb + (lw * 8 + ps * 4 + rr) * RW_STRIDE;
                    *(f32x4*)(o + seg * 4) = w[ps]; *(f32x4*)(o + 64 + seg * 4) = kp; *(f32x4*)(o + 128 + seg * 4) = -kk; *(f32x4*)(o + 192 + seg * 4) = bt; *(f32x4*)(o + 256 + seg * 4) = w[ps] * r[ps]; *(f32x4*)(o + 320 + seg * 4) = v[ps];
                    if (seg == 0) { o[384] = br; o[385] = kr; }
                }
                if (ci + 2 < T / RW_TC) {
#pragma unroll
                    for (int ps = 0; ps < 2; ++ps) { const size_t idx = ((size_t)b * T + (ci + 2) * RW_TC + lw * 8 + ps * 4 + rr) * 1024 + c;
                        r[ps] = *(const f32x4*)(Rr + idx); k[ps] = *(const f32x4*)(Kk + idx); v[ps] = *(const f32x4*)(Vv + idx); w[ps] = *(const f32x4*)(Wd + idx); a[ps] = *(const f32x4*)(Aa + idx); }
                }
                LDS_BARRIER();
            }
            if (cdp != nullptr) {
                if (!(cok & 1)) {
#pragma unroll
                    for (int j = 0; j < 32; ++j) cv[j] = 0.f; }
#pragma unroll
                for (int j = 0; j < 4; ++j) *(bf16x8*)(cdp + j * 8) = pack8(cv + j * 8);
            }
            LDS_BARRIER();
        } else {
            const int rr = lane >> 4, seg = lane & 15, vrow = 16 * q + 4 * wid + rr;
            f32x4 S = {0.f, 0.f, 0.f, 0.f};
            LDS_BARRIER();
            for (int ci = 0; ci < T / RW_TC; ++ci) {
                const float* bb = buf + (ci & 1) * (RW_TC * RW_STRIDE);
                f32x4 nw4, nk4, na4, nb4, nwr4; float nvv, nbr, nkr;
#define RW_LOADV(ss) do { const float* o_ = bb + (ss) * RW_STRIDE; nw4 = *(const f32x4*)(o_ + seg * 4); nk4 = *(const f32x4*)(o_ + 64 + seg * 4); na4 = *(const f32x4*)(o_ + 128 + seg * 4); \
                    nb4 = *(const f32x4*)(o_ + 192 + seg * 4); nwr4 = *(const f32x4*)(o_ + 256 + seg * 4); nvv = o_[320 + vrow]; nbr = o_[384]; nkr = o_[385]; } while (0)
                RW_LOADV(0);
#pragma unroll
                for (int s16 = 0; s16 < RW_TC / 16; ++s16) {
                    float ykeep = 0.f;
#pragma unroll
                    for (int s1 = 0; s1 < 16; ++s1) {
                        const f32x4 w4 = nw4, k4 = nk4, a4 = na4, b4 = nb4, wr4 = nwr4; const float vv = nvv, br = nbr, kr = nkr;
                        if (s16 * 16 + s1 + 1 < RW_TC) RW_LOADV(s16 * 16 + s1 + 1);
                        asm volatile("" ::: "memory");
                        typedef float f32x2_ __attribute__((ext_vector_type(2)));
                        const f32x2_ Slo = __builtin_shufflevector(S, S, 0, 1), Shi = __builtin_shufflevector(S, S, 2, 3);
                        f32x2_ t1 = Slo * __builtin_shufflevector(a4, a4, 0, 1); t1 = Shi * __builtin_shufflevector(a4, a4, 2, 3) + t1;
                        f32x2_ t2 = Slo * __builtin_shufflevector(wr4, wr4, 0, 1); t2 = Shi * __builtin_shufflevector(wr4, wr4, 2, 3) + t2;
                        const float p1 = t1[0] + t1[1], p2 = t2[0] + t2[1];
                        const float sa = dpp_sum16(p1), y0 = dpp_sum16(p2);
                        const float y = y0 + sa * br + vv * kr;
                        S = S * w4 + sa * b4 + vv * k4;
                        ykeep = (seg == s1) ? y : ykeep;
                    }
                    YS[((size_t)b * T + ci * RW_TC + s16 * 16 + seg) * 1024 + h * 64 + vrow] = ykeep;
                }
#undef RW_LOADV
                LDS_BARRIER();
            }
        }
    }
}

__device__ __forceinline__ void ph_rwkv_post(const Params* lp_) {
    const int tid_ = otid(); const int wid = tid_ >> 6, lane = tid_ & 63;
    const float* YS = (const float*)(rflp(lp_->ws) + OFF_H); const float* Vv = (const float*)(rflp(lp_->ws) + R_V); const float* RKB = (const float*)(rflp(lp_->ws) + R_LOR);
    const float* Gg = (const float*)(rflp(lp_->ws) + R_XM) + 2 * MS * 1024; bf16_t* YG = (bf16_t*)(rflp(lp_->ws) + OFF_XN);
    const float* ln_w = rflp(lp_->in[23]); const float* ln_b = rflp(lp_->in[24]);
    f32x4 lwv[4], lbv[4];
#pragma unroll
    for (int i = 0; i < 4; ++i) { lwv[i] = *(const f32x4*)(ln_w + lane * 16 + i * 4); lbv[i] = *(const f32x4*)(ln_b + lane * 16 + i * 4); }
    const int c0 = lane * 16; f32x4 ny[4], nv[4], ng[4]; float nrk; int row = blockIdx.x * 8 + wid;
#define RP_LOAD(rr_) do { _Pragma("unroll") for (int i = 0; i < 4; ++i) { const size_t idx_ = (size_t)(rr_) * 1024 + c0 + i * 4; ny[i] = *(const f32x4*)(YS + idx_); nv[i] = *(const f32x4*)(Vv + idx_); ng[i] = *(const f32x4*)(Gg + idx_); } \
        nrk = RKB[(size_t)(rr_) * 16 + (lane >> 2)]; } while (0)
    RP_LOAD(row);
    for (; row < M; row += gridDim.x * 8) {
        float y[16], out[16]; float s1 = 0.f; f32x4 vv[4], gg[4]; const float rk = nrk;
#pragma unroll
        for (int i = 0; i < 4; ++i) { vv[i] = nv[i]; gg[i] = ng[i];
#pragma unroll
            for (int j = 0; j < 4; ++j) { y[i * 4 + j] = ny[i][j]; s1 += ny[i][j]; } }
        if (row + (int)gridDim.x * 8 < M) RP_LOAD(row + gridDim.x * 8);
        s1 += __shfl_xor(s1, 1, 64); s1 += __shfl_xor(s1, 2, 64); const float mean = s1 * (1.f / 64.f);
        float s2 = 0.f;
#pragma unroll
        for (int i = 0; i < 16; ++i) { const float d = y[i] - mean; s2 += d * d; }
        s2 += __shfl_xor(s2, 1, 64); s2 += __shfl_xor(s2, 2, 64); const float inv = rsqrtf(s2 * (1.f / 64.f) + 64e-5f);
#pragma unroll
        for (int i = 0; i < 4; ++i) { const f32x4 lw = lwv[i], lb = lbv[i];
#pragma unroll
            for (int j = 0; j < 4; ++j) out[i * 4 + j] = ((y[i * 4 + j] - mean) * inv * lw[j] + lb[j] + rk * vv[i][j]) * gg[i][j]; }
        *(bf16x8*)(YG + (size_t)row * 1024 + c0) = pack8(out); *(bf16x8*)(YG + (size_t)row * 1024 + c0 + 8) = pack8(out + 8);
    }
#undef RP_LOAD
}

__device__ __forceinline__ void ph_ssd_prep(unsigned char* shm, const Params* lp_) {
    bf16_t* tl = (bf16_t*)shm; float* dtl = (float*)(shm + 64 * 136 * 2); float* carry = dtl + 128;
    const int tid = otid(), lane = tid & 63;
    const bf16_t* PROJ = (const bf16_t*)(rflp(lp_->ws) + S_PROJ); const float* DT = (const float*)(rflp(lp_->ws) + S_DT);
    bf16_t* BCN = (bf16_t*)(rflp(lp_->ws) + S_BCN); bf16_t* XDTT = (bf16_t*)(rflp(lp_->ws) + S_XDTT); bf16_t* BMT = (bf16_t*)(rflp(lp_->ws) + S_BMT); float* DTV = (float*)(rflp(lp_->ws) + S_DTV); float* ACS = (float*)(rflp(lp_->ws) + S_ACS);
    const float* convw = rflp(lp_->in[27]); const float* convb = rflp(lp_->in[28]); const float* dtb = rflp(lp_->in[29]); const float* a_log = rflp(lp_->in[30]);
    const int j = blockIdx.x % 48, gi = blockIdx.x / 48, gs = (int)(gridDim.x / 48) + ((int)(gridDim.x % 48) > j ? 1 : 0);
    const int l = tid >> 2, cb = (tid & 3) * 16; const int ch = j * 64 + cb;
    f32x4 wv[4][4], bv4[4];
#pragma unroll
    for (int jj = 0; jj < 4; ++jj)
#pragma unroll
        for (int i = 0; i < 4; ++i) wv[jj][i] = *(const f32x4*)(convw + jj * 3072 + ch + i * 4);
#pragma unroll
    for (int i = 0; i < 4; ++i) bv4[i] = *(const f32x4*)(convb + ch + i * 4);
    const float dtbj = j < 32 ? dtb[j] : 0.f, aj = j < 32 ? -__expf(a_log[j]) : 0.f;
    u32x4 xr[4][2]; float ndt = 0.f;
#define SP_LOAD(bc_) do { const int c_ = (bc_) & 31, b_ = (bc_) >> 5; const int tl_ = c_ * 128 + l; \
        _Pragma("unroll") for (int jj = 0; jj < 4; ++jj) { const int tt = tl_ - 3 + jj; const int ttc = tt < 0 ? 0 : tt; const bf16_t* src = PROJ + ((size_t)b_ * T + ttc) * 5376 + 2048 + ch; \
            xr[jj][0] = *(const u32x4*)src; xr[jj][1] = *(const u32x4*)(src + 8); } \
        if (j < 32 && tid < 128) ndt = DT[((size_t)b_ * T + c_ * 128 + tid) * 32 + j]; } while (0)
    if (gi < 128) SP_LOAD(gi);
    for (int bc = gi; bc < 128; bc += gs) {
        const int c = bc & 31, b = bc >> 5; const size_t row0 = (size_t)b * T + c * 128; const int tloc = c * 128 + l;
        LDS_BARRIER();
        if (j < 32 && tid < 128) {
            const float dt = softplusf_(ndt + dtbj); float da = dt * aj;
#pragma unroll
            for (int o = 1; o < 64; o <<= 1) { const float t = __shfl_up(da, o, 64); if (lane >= o) da += t; }
            dtl[tid] = dt; carry[1 + tid] = da; if (tid == 63) carry[0] = da;
        }
        LDS_BARRIER();
        if (j < 32 && tid < 128) {
            ACS[((size_t)bc * 32 + j) * 128 + tid] = carry[1 + tid] + (tid >= 64 ? carry[0] : 0.f);
            DTV[((size_t)bc * 32 + j) * 128 + tid] = dtl[tid];
        }
        float val[16];
#pragma unroll
        for (int i = 0; i < 4; ++i) { val[i * 4] = bv4[i][0]; val[i * 4 + 1] = bv4[i][1]; val[i * 4 + 2] = bv4[i][2]; val[i * 4 + 3] = bv4[i][3]; }
#pragma unroll
        for (int jj = 0; jj < 4; ++jj) { const float msk = (tloc - 3 + jj) < 0 ? 0.f : 1.f;
            const unsigned xw[8] = {xr[jj][0][0], xr[jj][0][1], xr[jj][0][2], xr[jj][0][3], xr[jj][1][0], xr[jj][1][1], xr[jj][1][2], xr[jj][1][3]};
#pragma unroll
            for (int i = 0; i < 4; ++i) { const f32x4 w = wv[jj][i] * msk; const unsigned xa = xw[2 * i], xb = xw[2 * i + 1];
                val[i * 4] += w[0] * lo_bf(xa); val[i * 4 + 1] += w[1] * hi_bf(xa); val[i * 4 + 2] += w[2] * lo_bf(xb); val[i * 4 + 3] += w[3] * hi_bf(xb); } }
        if (bc + gs < 128) SP_LOAD(bc + gs);
#pragma unroll
        for (int i = 0; i < 16; ++i) val[i] = siluf_(val[i]);
        if (j >= 32) { bf16_t* dst = BCN + (row0 + l) * 1024 + (j - 32) * 64 + cb; *(bf16x8*)dst = pack8(val); *(bf16x8*)(dst + 8) = pack8(val + 8); }
        if (j < 40) {
            const float sc = j < 32 ? dtl[l] : 1.f;
#pragma unroll
            for (int i = 0; i < 16; ++i) tl[(cb + i) * 136 + l] = f2bf(val[i] * sc);
            LDS_BARRIER();
            bf16_t* dbase = j < 32 ? XDTT + ((size_t)bc * 32 + j) * 64 * 128 : BMT + (((size_t)bc * 4 + ((j - 32) >> 1)) * 128 + ((j - 32) & 1) * 64) * 128;
#pragma unroll
            for (int i = 0; i < 2; ++i) { const int v = tid + 512 * i, col = v >> 4, l8 = (v & 15) * 8; *(u32x4*)(dbase + (size_t)col * 128 + l8) = *(const u32x4*)(tl + col * 136 + l8); }
        }
    }
#undef SP_LOAD
}

__device__ __forceinline__ void ph_ssd_states(unsigned char* shm, const Params* lp_) {
    float* ds = (float*)shm; bf16_t* BmL = (bf16_t*)(shm + 1024); bf16_t* XdL = BmL + 128 * 136;
    const int tid = otid(), wid = tid >> 6, lane = tid & 63, l15 = lane & 15, lq = lane >> 4;
    const bf16_t* XDTT = (const bf16_t*)(rflp(lp_->ws) + S_XDTT); const bf16_t* BMT = (const bf16_t*)(rflp(lp_->ws) + S_BMT); const float* ACS = (const float*)(rflp(lp_->ws) + S_ACS); bf16_t* ST = (bf16_t*)(rflp(lp_->ws) + OFF_H);
    u32x4 gb[4], gx[2]; float dsv = 0.f;
#define ST_TASK(t0_) ((((((t0_) & 7) * 64 + ((((t0_) >> 8) * 32 + (((t0_) & 255) >> 3)) >> 3)) >> 2) * 32) + (((((t0_) & 7) * 64 + ((((t0_) >> 8) * 32 + (((t0_) & 255) >> 3)) >> 3)) & 3) * 8) + ((((t0_) >> 8) * 32 + (((t0_) & 255) >> 3)) & 7))
#define ST_LOAD(t0_) do { const int tk_ = ST_TASK(t0_); const int h_ = tk_ & 31, bc_ = tk_ >> 5, g_ = h_ >> 3; \
        _Pragma("unroll") for (int i = 0; i < 4; ++i) { const int v = tid + 512 * i; gb[i] = *(const u32x4*)(BMT + (((size_t)bc_ * 4 + g_) * 128 + (v >> 4)) * 128 + (v & 15) * 8); } \
        _Pragma("unroll") for (int i = 0; i < 2; ++i) { const int v = tid + 512 * i; gx[i] = *(const u32x4*)(XDTT + ((size_t)tk_ * 64 + (v >> 4)) * 128 + (v & 15) * 8); } \
        if (tid < 128) dsv = ACS[(size_t)tk_ * 128 + 127] - ACS[(size_t)tk_ * 128 + tid]; } while (0)
    ST_LOAD(blockIdx.x);
    for (int task0 = blockIdx.x; task0 < 4096; task0 += gridDim.x) {
        const int task = ST_TASK(task0);
        LDS_BARRIER();
#pragma unroll
        for (int i = 0; i < 4; ++i) { const int v = tid + 512 * i; *(u32x4*)(BmL + (v >> 4) * 136 + (v & 15) * 8) = gb[i]; }
#pragma unroll
        for (int i = 0; i < 2; ++i) { const int v = tid + 512 * i; *(u32x4*)(XdL + (v >> 4) * 136 + (v & 15) * 8) = gx[i]; }
        if (tid < 128) ds[tid] = __expf(dsv);
        LDS_BARRIER();
        if (task0 + (int)gridDim.x < 4096) ST_LOAD(task0 + gridDim.x);
        f32x4 acc[4];
#pragma unroll
        for (int i = 0; i < 4; ++i) acc[i] = (f32x4){0.f, 0.f, 0.f, 0.f};
#pragma unroll
        for (int k = 0; k < 4; ++k) {
            const u32x4 braw = *(const u32x4*)(BmL + (16 * wid + l15) * 136 + k * 32 + lq * 8);
            const f32x4 d0 = *(const f32x4*)(ds + k * 32 + lq * 8), d1 = *(const f32x4*)(ds + k * 32 + lq * 8 + 4);
            float bv[8] = {lo_bf(braw[0]) * d0[0], hi_bf(braw[0]) * d0[1], lo_bf(braw[1]) * d0[2], hi_bf(braw[1]) * d0[3], lo_bf(braw[2]) * d1[0], hi_bf(braw[2]) * d1[1], lo_bf(braw[3]) * d1[2], hi_bf(braw[3]) * d1[3]};
            const bf16x8 bf = pack8(bv);
#pragma unroll
            for (int pt = 0; pt < 4; ++pt) { const bf16x8 af = *(const bf16x8*)(XdL + (16 * pt + l15) * 136 + k * 32 + lq * 8); acc[pt] = MFMA16(af, bf, acc[pt]); }
        }
#pragma unroll
        for (int pt = 0; pt < 4; ++pt)
#pragma unroll
            for (int j = 0; j < 4; ++j) ST[((size_t)task * 64 + 16 * pt + lq * 4 + j) * 128 + 16 * wid + l15] = f2bf(acc[pt][j]);
    }
}

#undef ST_LOAD
#undef ST_TASK
__device__ __forceinline__ void ph_ssd_chunkscan(const Params* lp_) {
    const bf16_t* ST = (const bf16_t*)(rflp(lp_->ws) + OFF_H); bf16_t* PREV = (bf16_t*)(rflp(lp_->ws) + OFF_Y); const float* ACS = (const float*)(rflp(lp_->ws) + S_ACS);
    for (int v = blockIdx.x * 512 + otid(); v < 4 * 32 * 64 * 16; v += gridDim.x * 512) {
        const int n8 = (v & 15) * 8, pp = (v >> 4) & 63, h = (v >> 10) & 31, b = v >> 15;
        float hc[8];
#pragma unroll
        for (int i = 0; i < 8; ++i) hc[i] = 0.f;
        const size_t task0 = (size_t)b * 32 * 32 + h; float nacs = ACS[task0 * 128 + 127]; u32x4 ns = *(const u32x4*)(ST + (task0 * 64 + pp) * 128 + n8);
        for (int c = 0; c < 32; ++c) {
            const size_t task = ((size_t)b * 32 + c) * 32 + h; const size_t off = (task * 64 + pp) * 128 + n8;
            *(bf16x8*)(PREV + off) = pack8(hc);
            const float dec = __expf(nacs); const u32x4 s = ns;
            if (c + 1 < 32) { const size_t tn_ = task + 32; nacs = ACS[tn_ * 128 + 127]; ns = *(const u32x4*)(ST + (tn_ * 64 + pp) * 128 + n8); }
#pragma unroll
            for (int i = 0; i < 4; ++i) { hc[2 * i] = dec * hc[2 * i] + lo_bf(s[i]); hc[2 * i + 1] = dec * hc[2 * i + 1] + hi_bf(s[i]); }
        }
    }
}

__device__ __forceinline__ void ph_ssd_out(unsigned char* shm, const Params* lp_) {
    const int tid = otid(), wid = tid >> 6, lane = tid & 63, l15 = lane & 15, lq = lane >> 4;
    float* acs = (float*)shm; float* dtl = acs + 128; bf16_t* BmL = (bf16_t*)(shm + 1024); bf16_t* XdL = BmL + 128 * 136; bf16_t* PvL = XdL + 64 * 136; bf16_t* sc = PvL + 64 * 136 + wid * (16 * 136);
    const bf16_t* PROJ = (const bf16_t*)(rflp(lp_->ws) + S_PROJ); const bf16_t* BCN = (const bf16_t*)(rflp(lp_->ws) + S_BCN); const bf16_t* XDTT = (const bf16_t*)(rflp(lp_->ws) + S_XDTT);
    const bf16_t* PREV = (const bf16_t*)(rflp(lp_->ws) + OFF_Y); const float* DTV = (const float*)(rflp(lp_->ws) + S_DTV); const float* ACS = (const float*)(rflp(lp_->ws) + S_ACS); bf16_t* YS = (bf16_t*)(rflp(lp_->ws) + OFF_H);
    const float* dsk = rflp(lp_->in[31]);
    for (int task0 = blockIdx.x; task0 < 4096; task0 += gridDim.x) {
        const int slot_ = (task0 >> 8) * 32 + ((task0 & 255) >> 3); const int G_ = (task0 & 7) * 64 + (slot_ >> 3); const int task = (G_ >> 2) * 32 + (G_ & 3) * 8 + (slot_ & 7);
        const int h = task & 31, bc = task >> 5, g = h >> 3, c = bc & 31, b = bc >> 5; const size_t row0 = (size_t)b * T + c * 128;
        const int l0 = 16 * wid + lq * 4;
        u32x4 gb[4], gx[2], gp[2]; bf16x8 Cf[4]; bf16_t zz[4][4];
#pragma unroll
        for (int i = 0; i < 4; ++i) { const int v = tid + 512 * i; gb[i] = *(const u32x4*)(BCN + (row0 + (v >> 4)) * 1024 + g * 128 + (v & 15) * 8); }
#pragma unroll
        for (int i = 0; i < 2; ++i) { const int v = tid + 512 * i; gx[i] = *(const u32x4*)(XDTT + ((size_t)task * 64 + (v >> 4)) * 128 + (v & 15) * 8); gp[i] = *(const u32x4*)(PREV + ((size_t)task * 64 + (v >> 4)) * 128 + (v & 15) * 8); }
#pragma unroll
        for (int k = 0; k < 4; ++k) Cf[k] = *(const bf16x8*)(BCN + (row0 + 16 * wid + l15) * 1024 + 512 + g * 128 + k * 32 + lq * 8);
#pragma unroll
        for (int pt = 0; pt < 4; ++pt)
#pragma unroll
            for (int j = 0; j < 4; ++j) zz[pt][j] = PROJ[(row0 + l0 + j) * 5376 + h * 64 + 16 * pt + l15];
        float av = 0.f, dv = 0.f; if (tid < 128) { av = ACS[(size_t)task * 128 + tid]; dv = DTV[(size_t)task * 128 + tid]; }
        LDS_BARRIER();
#pragma unroll
        for (int i = 0; i < 4; ++i) { const int v = tid + 512 * i; *(u32x4*)(BmL + (v >> 4) * 136 + (v & 15) * 8) = gb[i]; }
#pragma unroll
        for (int i = 0; i < 2; ++i) { const int v = tid + 512 * i; *(u32x4*)(XdL + (v >> 4) * 136 + (v & 15) * 8) = gx[i]; *(u32x4*)(PvL + (v >> 4) * 136 + (v & 15) * 8) = gp[i]; }
        if (tid < 128) { acs[tid] = av; dtl[tid] = dv; }
        LDS_BARRIER();
        const int nst = (wid | 1) + 1;
        for (int st = 0; st < nst; ++st) {
            f32x4 cb = {0.f, 0.f, 0.f, 0.f};
#pragma unroll
            for (int k = 0; k < 4; ++k) { const bf16x8 bf = *(const bf16x8*)(BmL + (16 * st + l15) * 136 + k * 32 + lq * 8); cb = MFMA16(Cf[k], bf, cb); }
            const int sx = 16 * st + l15; const float as = acs[sx];
#pragma unroll
            for (int j = 0; j < 4; ++j) { const int ll = l0 + j; sc[(lq * 4 + j) * 136 + sx] = f2bf(ll >= sx ? cb[j] * __expf(acs[ll] - as) : 0.f); }
        }
        LDS_BARRIER();
        f32x4 yd[4], yo[4];
#pragma unroll
        for (int i = 0; i < 4; ++i) { yd[i] = (f32x4){0.f, 0.f, 0.f, 0.f}; yo[i] = (f32x4){0.f, 0.f, 0.f, 0.f}; }
        const int nks = (wid >> 1) + 1;
        for (int k = 0; k < nks; ++k) { const bf16x8 af = *(const bf16x8*)(sc + l15 * 136 + k * 32 + lq * 8);
#pragma unroll
            for (int pt = 0; pt < 4; ++pt) { const bf16x8 bf = *(const bf16x8*)(XdL + (16 * pt + l15) * 136 + k * 32 + lq * 8); yd[pt] = MFMA16(af, bf, yd[pt]); } }
#pragma unroll
        for (int k = 0; k < 4; ++k)
#pragma unroll
            for (int pt = 0; pt < 4; ++pt) { const bf16x8 bf = *(const bf16x8*)(PvL + (16 * pt + l15) * 136 + k * 32 + lq * 8); yo[pt] = MFMA16(Cf[k], bf, yo[pt]); }
        const float dh = dsk[h];
#pragma unroll
        for (int pt = 0; pt < 4; ++pt) { const int pp = 16 * pt + l15; const u32x2 xr = *(const u32x2*)(XdL + pp * 136 + l0);
            const float xd[4] = {lo_bf(xr[0]), hi_bf(xr[0]), lo_bf(xr[1]), hi_bf(xr[1])};
#pragma unroll
            for (int j = 0; j < 4; ++j) { const int ll = l0 + j; float y = yd[pt][j] + __expf(acs[ll]) * yo[pt][j] + dh * xd[j] / dtl[ll];
                y *= siluf_(bf2f(zz[pt][j]));
                YS[(row0 + ll) * 2048 + h * 64 + pp] = f2bf(y); } }
    }
}

__device__ __forceinline__ void ph_ssd_norm(const Params* lp_) {
    const int tid_ = otid(); const int wid = tid_ >> 6, lane = tid_ & 63;
    const bf16_t* YS = (const bf16_t*)(rflp(lp_->ws) + OFF_H); bf16_t* YN = (bf16_t*)(rflp(lp_->ws) + S_XDTT); const float* nw = rflp(lp_->in[32]);
    f32x4 nwv[8];
#pragma unroll
    for (int i = 0; i < 8; ++i) nwv[i] = *(const f32x4*)(nw + lane * 32 + i * 4);
    const int c0 = lane * 32; u32x4 nt[4]; int row = blockIdx.x * 8 + wid;
#pragma unroll
    for (int i = 0; i < 4; ++i) nt[i] = *(const u32x4*)(YS + (size_t)row * 2048 + c0 + i * 8);
    for (; row < M; row += gridDim.x * 8) {
        float y[32]; float ss = 0.f;
#pragma unroll
        for (int i = 0; i < 4; ++i) { const u32x4 t = nt[i];
#pragma unroll
            for (int j = 0; j < 4; ++j) { y[i * 8 + 2 * j] = lo_bf(t[j]); y[i * 8 + 2 * j + 1] = hi_bf(t[j]); } }
        if (row + (int)gridDim.x * 8 < M) {
#pragma unroll
            for (int i = 0; i < 4; ++i) nt[i] = *(const u32x4*)(YS + (size_t)(row + gridDim.x * 8) * 2048 + c0 + i * 8); }
#pragma unroll
        for (int i = 0; i < 32; ++i) ss += y[i] * y[i];
        ss += __shfl_xor(ss, 1, 64); ss += __shfl_xor(ss, 2, 64); ss += __shfl_xor(ss, 4, 64); ss += __shfl_xor(ss, 8, 64);
        const float inv = rsqrtf(ss * (1.f / 512.f) + 1e-5f);
#pragma unroll
        for (int i = 0; i < 8; ++i) { const f32x4 w = nwv[i];
#pragma unroll
            for (int j = 0; j < 4; ++j) y[i * 4 + j] *= inv * w[j]; }
#pragma unroll
        for (int i = 0; i < 4; ++i) *(bf16x8*)(YN + (size_t)row * 2048 + c0 + i * 8) = pack8(y + i * 8);
    }
}

__device__ __forceinline__ void ph_lru_conv(const Params* lp_) {
    const float* PROJ = (const float*)(rflp(lp_->ws) + L_PROJ); bf16_t* U = (bf16_t*)(rflp(lp_->ws) + L_U); const float* cw = rflp(lp_->in[35]); const float* cbias = rflp(lp_->in[36]);
    const int v0_ = blockIdx.x * 512 + otid(); const int cfix = (v0_ & 255) * 4;
    f32x4 cwv[4]; const f32x4 cbv = *(const f32x4*)(cbias + cfix);
#pragma unroll
    for (int j = 0; j < 4; ++j) cwv[j] = *(const f32x4*)(cw + j * 1024 + cfix);
    const int c = cfix; f32x4 nx[4]; int v = v0_;
#define CONV_LOAD(vv_) do { const int r_ = (vv_) >> 8, t_ = r_ & (T - 1); _Pragma("unroll") for (int j = 0; j < 4; ++j) { const int rj_ = (t_ - 3 + j) >= 0 ? r_ - 3 + j : r_; nx[j] = *(const f32x4*)(PROJ + (size_t)rj_ * 2048 + 1024 + c); } } while (0)
    CONV_LOAD(v);
    for (; v < M * 256; v += gridDim.x * 512) {
        const int row = v >> 8, t = row & (T - 1);
        f32x4 a = cbv;
#pragma unroll
        for (int j = 0; j < 4; ++j) { const float msk = (t - 3 + j) >= 0 ? 1.f : 0.f; a += (cwv[j] * msk) * nx[j]; }
        if (v + (int)gridDim.x * 512 < M * 256) CONV_LOAD(v + gridDim.x * 512);
        const u32x2 o = {cvt_pk_bf16(a[0], a[1]), cvt_pk_bf16(a[2], a[3])}; *(u32x2*)(U + (size_t)row * 1024 + c) = o;
    }
#undef CONV_LOAD
}
__device__ __forceinline__ void ph_lru_scan(unsigned char* shm, const Params* lp_) {
    float* segA = (float*)shm; float* segH = segA + 512;
    const float* AA = (const float*)(rflp(lp_->ws) + L_AA); const float* BB = (const float*)(rflp(lp_->ws) + L_BB); const float* PROJ = (const float*)(rflp(lp_->ws) + L_PROJ); bf16_t* YL = (bf16_t*)(rflp(lp_->ws) + OFF_XN);
    const int tid = otid(), chl = tid & 15, seg = tid >> 4;
    for (int item = blockIdx.x; item < 256; item += gridDim.x) {
        const int b = item >> 6, cg = item & 63, ch = cg * 16 + chl; const size_t base = ((size_t)b * T + seg * 128) * 1024 + ch;
        const size_t gbase = ((((size_t)b * 64 + cg) * 4096 + seg * 128) << 4) + chl;
        float A = 1.f, hh = 0.f;
        float na[8], nb[8], ng[8];
#pragma unroll
        for (int j = 0; j < 8; ++j) { na[j] = AA[gbase + (size_t)j * 16]; nb[j] = BB[gbase + (size_t)j * 16]; }
        for (int t8 = 0; t8 < 128; t8 += 8) {
            float ca[8], cb[8];
#pragma unroll
            for (int j = 0; j < 8; ++j) { ca[j] = na[j]; cb[j] = nb[j]; }
            if (t8 + 8 < 128) {
#pragma unroll
                for (int j = 0; j < 8; ++j) { na[j] = AA[gbase + (size_t)(t8 + 8 + j) * 16]; nb[j] = BB[gbase + (size_t)(t8 + 8 + j) * 16]; } }
#pragma unroll
            for (int j = 0; j < 8; ++j) { hh = ca[j] * hh + cb[j]; A *= ca[j]; }
        }
        __syncthreads();
        segA[seg * 16 + chl] = A; segH[seg * 16 + chl] = hh;
        __syncthreads();
        float hin = 0.f;
        for (int s = 0; s < seg; ++s) hin = segA[s * 16 + chl] * hin + segH[s * 16 + chl];
        hh = hin;
#pragma unroll
        for (int j = 0; j < 8; ++j) { na[j] = AA[gbase + (size_t)j * 16]; nb[j] = BB[gbase + (size_t)j * 16]; ng[j] = PROJ[((size_t)b * T + seg * 128 + j) * 2048 + ch]; }
        for (int t8 = 0; t8 < 128; t8 += 8) {
            float ca[8], cb[8], cg[8];
#pragma unroll
            for (int j = 0; j < 8; ++j) { ca[j] = na[j]; cb[j] = nb[j]; cg[j] = ng[j]; }
            if (t8 + 8 < 128) {
#pragma unroll
                for (int j = 0; j < 8; ++j) { na[j] = AA[gbase + (size_t)(t8 + 8 + j) * 16]; nb[j] = BB[gbase + (size_t)(t8 + 8 + j) * 16]; ng[j] = PROJ[((size_t)b * T + seg * 128 + t8 + 8 + j) * 2048 + ch]; } }
#pragma unroll
            for (int j = 0; j < 8; ++j) { hh = ca[j] * hh + cb[j]; YL[base + (size_t)(t8 + j) * 1024] = f2bf(gelu_tanh(cg[j]) * hh); }
        }
    }
}

#define XB_TMO      128
#define XB_XCNT(j)  (256  + 64 * (j))
#define XB_XSUB(j)  (1280 + 64 * (j))
#define XB_XGEN(j)  (2304 + 64 * (j))
#define XB_TOP      3328
#define XB_TOPGEN   3392
#define XCD_BAR_WORDS 3456
#define XB_SPIN_CAP (1u << 22)
__device__ __forceinline__ unsigned xb_ld(unsigned* p)              { return __hip_atomic_load(p, __ATOMIC_RELAXED, __HIP_MEMORY_SCOPE_AGENT); }
__device__ __forceinline__ unsigned xb_add(unsigned* p, unsigned v) { return __hip_atomic_fetch_add(p, v, __ATOMIC_RELAXED, __HIP_MEMORY_SCOPE_AGENT); }
__device__ __forceinline__ unsigned xb_xcc_id() { return (unsigned)__builtin_amdgcn_s_getreg((3 << 11) | 20) & 0xFu; }
#define XB_SPIN(cond, bar) do { unsigned _sp = 0; while (cond) { __builtin_amdgcn_s_sleep(1); \
    if ((++_sp & 255u) == 0u) { if (xb_ld(&(bar)[XB_TMO])) break; if (_sp > XB_SPIN_CAP) { atomicAdd(&(bar)[XB_TMO], 1u); break; } } } } while (0)
struct XcdBarrier { unsigned* bar; unsigned x; volatile LAS unsigned* st; };
__device__ __forceinline__ XcdBarrier xcd_barrier_post(unsigned* bar, volatile LAS unsigned* st) {
    XcdBarrier b; b.bar = bar; b.x = xb_xcc_id(); b.st = st;
    if (threadIdx.x == 0) (void)xb_add(&bar[XB_XCNT(b.x)], 1u);
    return b;
}
__device__ __forceinline__ void xcd_barrier_complete(unsigned* bar, unsigned x, unsigned& nloc, unsigned& nx) {
    const unsigned G = gridDim.x * gridDim.y * gridDim.z;
    unsigned sum, cnt, mine, sp = 0u;
    for (;;) {
        sum = 0u; cnt = 0u; mine = 0u;
#pragma unroll
        for (unsigned j = 0; j < 16; ++j) { const unsigned c = xb_ld(&bar[XB_XCNT(j)]); sum += c; cnt += (c > 0u) ? 1u : 0u; mine = (j == x) ? c : mine; }
        if (sum == G) break;
        __builtin_amdgcn_s_sleep(1);
        if ((++sp & 255u) == 0u) { if (xb_ld(&bar[XB_TMO])) break; if (sp > XB_SPIN_CAP) { atomicAdd(&bar[XB_TMO], 1u); break; } }
    }
    nloc = mine > 0u ? mine : 1u; nx = cnt > 0u ? cnt : 1u;
}
__device__ __forceinline__ void xcd_barrier(const XcdBarrier& b) {
    asm volatile("s_waitcnt vmcnt(0)" ::: "memory");
    __syncthreads();
    if (threadIdx.x == 0) {
        unsigned* bar = b.bar;
        __builtin_amdgcn_s_waitcnt(0);
        unsigned nloc = b.st[0], nx = b.st[1];
        if (nloc == 0u) { xcd_barrier_complete(bar, b.x, nloc, nx); b.st[0] = nloc; b.st[1] = nx; }
        const unsigned old = xb_add(&bar[XB_XSUB(b.x)], 1u);
        const unsigned gen = old / nloc;
        if (old + 1u == (gen + 1u) * nloc) {
            __builtin_amdgcn_fence(__ATOMIC_RELEASE, "agent");
            asm volatile("s_waitcnt vmcnt(0)" ::: "memory");
            const unsigned og = xb_add(&bar[XB_TOP], 1u);
            const unsigned tg = og / nx;
            if (og + 1u == (tg + 1u) * nx) xb_add(&bar[XB_TOPGEN], 1u);
            else XB_SPIN(xb_ld(&bar[XB_TOPGEN]) == tg, bar);
            __builtin_amdgcn_fence(__ATOMIC_ACQUIRE, "agent");
            xb_add(&bar[XB_XGEN(b.x)], 1u);
            asm volatile("s_waitcnt vmcnt(0)" ::: "memory");
        } else {
            XB_SPIN(xb_ld(&bar[XB_XGEN(b.x)]) == gen, bar);
            __builtin_amdgcn_fence(__ATOMIC_ACQUIRE, "agent");
            asm volatile("s_waitcnt vmcnt(0)" ::: "memory");
        }
    }
    __syncthreads();
}

enum { OP_FFN1 = 0, OP_FFN2, OP_ROW_A, OP_ROW_B, OP_ROW_M, OP_MIX_OUT, OP_GDN_IN, OP_GDN_PREP, OP_GDN_SCAN, OP_GDN_GATE, OP_RW_MIX, OP_RW_G1, OP_RW_G2, OP_RW_SCAN, OP_RW_POST,
       OP_SSD_IN, OP_SSD_PREP, OP_SSD_STATES, OP_SSD_CSCAN, OP_SSD_OUT, OP_SSD_NORM, OP_LRU_IN, OP_LRU_CONV, OP_LRU_GATES, OP_LRU_SCAN, OP_PREP, OP_END };
constexpr int LDS_PROG_OFF = LDS_DESC_OFF + 1024;
struct Step { int op, layer, half, d0, nd; };
struct Program { Step steps[72]; DescC descs[40]; };
constexpr DescC mk(size_t A, size_t Bt, size_t C, int lda, int ldb, int ldc, int K, int N, int epi, int perm, int aux = 0, int aux2 = 0, size_t side = 0) {
    return DescC{A, Bt, C, side, lda, ldb, ldc, K / BK, M / BM, N / BM, epi, perm, aux, aux2};
}
constexpr Program make_program() {
    Program P{}; int ns = 0, ndc = 0;
    P.steps[ns++] = Step{OP_PREP, 0, 0, 0, 0};
    for (int layer = 0; layer < 4; ++layer) {
        for (int half = 0; half < 2; ++half) {
            P.descs[ndc] = mk(OFF_XN, OFF_WF_IN + (layer * 2 + half) * SZ_WF_IN1, OFF_H, 1024, 1024, 2816, 1024, 5632, EPI_SWIGLU, 1);
            P.steps[ns++] = Step{OP_FFN1, layer, half, ndc++, 1};
            P.descs[ndc] = mk(OFF_H, OFF_WF_OUT + (layer * 2 + half) * SZ_WF_OUT1, OFF_Y, 2816, 2816, 1024, 2816, 1024, EPI_F32, 0);
            P.steps[ns++] = Step{OP_FFN2, layer, half, ndc++, 1};
            P.steps[ns++] = Step{half == 0 ? OP_ROW_A : OP_ROW_B, layer, half, 0, 0};
            if (half == 1) break;
            if (layer == 0) {
                P.descs[ndc] = mk(OFF_XN, OFF_W_GDN_IN, G_PROJ, 1024, 1024, 4352, 1024, 4352, EPI_BF16, 1, 16, 16, G_BA);
                P.steps[ns++] = Step{OP_GDN_IN, layer, 0, ndc++, 1};
                P.steps[ns++] = Step{OP_GDN_PREP, layer, 0, 0, 0}; P.steps[ns++] = Step{OP_GDN_SCAN, layer, 0, 0, 0}; P.steps[ns++] = Step{OP_GDN_GATE, layer, 0, 0, 0};
                P.descs[ndc] = mk(OFF_XN, OFF_W_GDN_OUT, OFF_Y, 1024, 1024, 1024, 1024, 1024, EPI_F32, 0);
            } else if (layer == 1) {
                P.steps[ns++] = Step{OP_RW_MIX, layer, 0, 0, 0};
                const int d0 = ndc;
                for (int i = 0; i < 3; ++i) P.descs[ndc++] = mk(R_XM + i * 1024 * 2, OFF_W_RKV + (size_t)i * 1024 * 1024 * 2, i == 0 ? OFF_Y : (i == 1 ? R_K : R_V), 6144, 1024, 1024, 1024, 1024, EPI_F32, 0);
                for (int i = 0; i < 3; ++i) P.descs[ndc++] = mk(R_XM + (3 + i) * 1024 * 2, OFF_W_L1 + (size_t)i * 256 * 1024 * 2, R_LOR, 6144, 1024, 256, 1024, 256, EPI_LORA1, 1, i);
                P.steps[ns++] = Step{OP_RW_G1, layer, 0, d0, 6};
                P.descs[ndc] = mk(R_LOR, OFF_W_L2, R_XM, 256, 256, 1024, 256, 3072, EPI_WAG, 0);
                P.steps[ns++] = Step{OP_RW_G2, layer, 0, ndc++, 1};
                P.steps[ns++] = Step{OP_RW_SCAN, layer, 0, 0, 0}; P.steps[ns++] = Step{OP_RW_POST, layer, 0, 0, 0};
                P.descs[ndc] = mk(OFF_XN, OFF_W_R_OUT, OFF_Y, 1024, 1024, 1024, 1024, 1024, EPI_F32, 0);
            } else if (layer == 2) {
                P.descs[ndc] = mk(OFF_XN, OFF_W_SSD_IN, S_PROJ, 1024, 1024, 5376, 1024, 5376, EPI_BF16, 1, 20, 32, S_DT);
                P.steps[ns++] = Step{OP_SSD_IN, layer, 0, ndc++, 1};
                P.steps[ns++] = Step{OP_SSD_PREP, layer, 0, 0, 0}; P.steps[ns++] = Step{OP_SSD_STATES, layer, 0, 0, 0}; P.steps[ns++] = Step{OP_SSD_CSCAN, layer, 0, 0, 0};
                P.steps[ns++] = Step{OP_SSD_OUT, layer, 0, 0, 0}; P.steps[ns++] = Step{OP_SSD_NORM, layer, 0, 0, 0};
                P.descs[ndc] = mk(S_XDTT, OFF_W_SSD_OUT, OFF_Y, 2048, 2048, 1024, 2048, 1024, EPI_F32, 0);
            } else {
                P.descs[ndc] = mk(OFF_XN, OFF_W_LRU_IN, L_PROJ, 1024, 1024, 2048, 1024, 2048, EPI_F32, 0);
                P.steps[ns++] = Step{OP_LRU_IN, layer, 0, ndc++, 1};
                P.steps[ns++] = Step{OP_LRU_CONV, layer, 0, 0, 0};
                const int d0 = ndc;
                for (int i = 0; i < 4; ++i) P.descs[ndc++] = mk(L_U + i * 256 * 2, OFF_W_LRU_G + (size_t)i * 512 * 256 * 2, 0, 1024, 256, 0, 256, 512, EPI_LRU, 0, i);
                P.steps[ns++] = Step{OP_LRU_GATES, layer, 0, d0, 4};
                P.steps[ns++] = Step{OP_LRU_SCAN, layer, 0, 0, 0};
                P.descs[ndc] = mk(OFF_XN, OFF_W_LRU_OUT, OFF_Y, 1024, 1024, 1024, 1024, 1024, EPI_F32, 0);
            }
            P.steps[ns++] = Step{OP_MIX_OUT, layer, 0, ndc++, 1};
            P.steps[ns++] = Step{OP_ROW_M, layer, 0, 0, 0};
        }
    }
    P.steps[ns++] = Step{OP_END, 0, 0, 0, 0};
    return P;
}
__constant__ Program PROGC = make_program();

__device__ __forceinline__ void weight_jobs(float* tile, const Params* lp_, int set, int bid, int nb) {
    unsigned char* ws = rflp(lp_->ws);
    for (int jq = 0; jq < 36; ++jq) {
        int myset = 2;
        if (jq < 4 || jq == 16 || jq == 17) myset = 0;
        else if ((jq >= 4 && jq < 8) || (jq >= 18 && jq <= 24) || jq >= 33) myset = 1;
        if (myset != set) continue;
        const float* src; int K, Ns, Nd, ldd, koff = 0, half = 0, rowoff = 0; bf16_t* dst;
        const int jb = jq - 16;
        if (jq < 16) { const int i = jq >> 1;
            if ((jq & 1) == 0) { src = rflp(lp_->in[2]) + (size_t)i * 1024 * 5632; K = 1024; Ns = 5632; Nd = 5632; dst = (bf16_t*)(ws + OFF_WF_IN + i * SZ_WF_IN1); ldd = 1024; half = 2816; }
            else { src = rflp(lp_->in[3]) + (size_t)i * 2816 * 1024; K = 2816; Ns = 1024; Nd = 1024; dst = (bf16_t*)(ws + OFF_WF_OUT + i * SZ_WF_OUT1); ldd = 2816; } }
        else switch (jb) {
            case 0: src = rflp(lp_->in[4]); K = 1024; Ns = 4112; Nd = 4352; dst = (bf16_t*)(ws + OFF_W_GDN_IN); ldd = 1024; break;
            case 1: src = rflp(lp_->in[9]); K = 1024; Ns = 1024; Nd = 1024; dst = (bf16_t*)(ws + OFF_W_GDN_OUT); ldd = 1024; break;
            case 2: case 3: case 4: src = rflp(lp_->in[11]) + (size_t)(jb - 2) * 1024 * 1024; K = 1024; Ns = 1024; Nd = 1024; dst = (bf16_t*)(ws + OFF_W_RKV) + (size_t)(jb - 2) * 1024 * 1024; ldd = 1024; break;
            case 5: src = rflp(lp_->in[13]); K = 1024; Ns = 64; Nd = 64; dst = (bf16_t*)(ws + OFF_W_L1); ldd = 1024; break;
            case 6: src = rflp(lp_->in[16]); K = 1024; Ns = 64; Nd = 64; dst = (bf16_t*)(ws + OFF_W_L1) + 256 * 1024; ldd = 1024; break;
            case 7: src = rflp(lp_->in[18]); K = 1024; Ns = 128; Nd = 128; dst = (bf16_t*)(ws + OFF_W_L1) + 2 * 256 * 1024; ldd = 1024; break;
            case 8: src = rflp(lp_->in[25]); K = 1024; Ns = 1024; Nd = 1024; dst = (bf16_t*)(ws + OFF_W_R_OUT); ldd = 1024; break;
            case 9: src = rflp(lp_->in[26]); K = 1024; Ns = 5152; Nd = 5376; dst = (bf16_t*)(ws + OFF_W_SSD_IN); ldd = 1024; break;
            case 10: src = rflp(lp_->in[33]); K = 2048; Ns = 1024; Nd = 1024; dst = (bf16_t*)(ws + OFF_W_SSD_OUT); ldd = 2048; break;
            case 11: src = rflp(lp_->in[34]); K = 1024; Ns = 2048; Nd = 2048; dst = (bf16_t*)(ws + OFF_W_LRU_IN); ldd = 1024; break;
            case 12: case 13: case 14: case 15: src = rflp(lp_->in[37]) + (size_t)(jb - 12) * 256 * 512; K = 256; Ns = 512; Nd = 512; dst = (bf16_t*)(ws + OFF_W_LRU_G) + (size_t)(jb - 12) * 512 * 256; ldd = 256; half = 256; break;
            case 16: src = rflp(lp_->in[40]); K = 1024; Ns = 1024; Nd = 1024; dst = (bf16_t*)(ws + OFF_W_LRU_OUT); ldd = 1024; break;
            case 17: src = rflp(lp_->in[14]); K = 64; Ns = 1024; Nd = 1024; dst = (bf16_t*)(ws + OFF_W_L2); ldd = 256; break;
            case 18: src = rflp(lp_->in[17]); K = 64; Ns = 1024; Nd = 1024; dst = (bf16_t*)(ws + OFF_W_L2); ldd = 256; koff = 64; rowoff = 1024; break;
            default: src = rflp(lp_->in[19]); K = 128; Ns = 1024; Nd = 1024; dst = (bf16_t*)(ws + OFF_W_L2); ldd = 256; koff = 128; rowoff = 2048; break;
        }
        tr_job(tile, src, K, Ns, Nd, dst, ldd, koff, half, rowoff, bid, nb);
    }
    { bf16_t* z = (bf16_t*)(ws + OFF_W_L2);
      if (set == 1) for (int v = bid * 512 + otid(); v < 3072 * 32; v += nb * 512) { const int row = v >> 5, c8 = (v & 31) * 8; const int blk = row >> 10;
          const bool used = blk == 0 ? (c8 < 64) : (blk == 1 ? (c8 >= 64 && c8 < 128) : (c8 >= 128));
          if (!used) { unsigned zz = 0u; asm volatile("" : "+v"(zz)); *(u32x4*)(z + (size_t)row * 256 + c8) = (u32x4){zz, zz, zz, zz}; } } }
}

__global__ void __launch_bounds__(512) mega(Params p) {
    extern __shared__ __attribute__((aligned(16))) unsigned char shm[];
    cg::grid_group grid = cg::this_grid();
    LAS unsigned char* lds = (LAS unsigned char*)shm;
    Params* lp = (Params*)(shm + LDS_PROG_OFF + 256);
    if (threadIdx.x == 0) {
#pragma unroll
        for (int i = 0; i < 41; ++i) lp->in[i] = p.in[i];
        lp->out = p.out; lp->ws = p.ws;
    }
    volatile LAS unsigned* xst = (volatile LAS unsigned*)(lds + LDS_PROG_OFF + 1024);
    if (threadIdx.x == 0) { xst[0] = 0u; xst[1] = 0u; xst[2] = 0u; xst[3] = 0u; }
    __syncthreads();
    (void)xcd_barrier_post((unsigned*)(rflp(lp->ws) + OFF_BAR), xst);
    for (int pc = 0, rrep = 0;; ++pc) {
        const Step* st = &PROGC.steps[pc];
        const int op = rfl(st->op), layer = rfl(st->layer), d0 = rfl(st->d0), nd = rfl(st->nd);
        if (op == OP_END) break;
        if (nd) gemm_phase(lds, &PROGC.descs[d0], nd, lp);
        else if (op == OP_PREP) {
            unsigned char* ws = rflp(lp->ws);
            weight_jobs((float*)shm, lp, 0, blockIdx.x, gridDim.x);
            ph_firstnorm(rflp(lp->in[0]), rflp(lp->out), rflp(lp->in[1]), (bf16_t*)(ws + OFF_XN));
        } else if (op == OP_ROW_A || op == OP_ROW_B || op == OP_ROW_M) {
            unsigned char* ws = rflp(lp->ws);
            const float* g = rflp(lp->in[1]) + (size_t)layer * 6 * 1024;
            const int ia = op == OP_ROW_A ? 1 : (op == OP_ROW_M ? 3 : 5);
            const bool has_gb = !(op == OP_ROW_B && layer == 3);
            ph_rowpass(rflp(lp->out), (const float*)(ws + OFF_Y), op == OP_ROW_M ? 1.f : 0.5f, g + ia * 1024, g + (has_gb ? ia + 1 : ia) * 1024, (bf16_t*)(ws + OFF_XN), has_gb);
        } else switch (op) {
            case OP_GDN_PREP: ph_gdn_prep(shm, lp); break;
            case OP_GDN_SCAN: if (blockIdx.x < 128) ph_gdn_scan(shm, lp); else weight_jobs((float*)shm, lp, 1, blockIdx.x - 128, gridDim.x - 128); break;
            case OP_GDN_GATE: ph_gdn_gate(lp); break;
            case OP_RW_MIX: ph_rwkv_mix(lp); break;
            case OP_RW_SCAN: ph_rwkv_scan(shm, lp); break;
            case OP_RW_POST: ph_rwkv_post(lp); break;
            case OP_SSD_PREP: ph_ssd_prep(shm, lp); break;
            case OP_SSD_STATES: ph_ssd_states(shm, lp); break;
            case OP_SSD_CSCAN: ph_ssd_chunkscan(lp); break;
            case OP_SSD_OUT: ph_ssd_out(shm, lp); break;
            case OP_SSD_NORM: ph_ssd_norm(lp); break;
            case OP_LRU_CONV: ph_lru_conv(lp); break;
            case OP_LRU_SCAN: ph_lru_scan(shm, lp); break;
            default: break;
        }
#ifdef PROBE_REP
        { int rep = 1; PROBE_REP; if (rrep + 1 < rep) { ++rrep; --pc; } else rrep = 0; }
#endif
        if (lp->ws == nullptr) grid.sync();
        { XcdBarrier xb; xb.bar = (unsigned*)(rflp(lp->ws) + OFF_BAR); xb.x = xb_xcc_id(); xb.st = xst; xcd_barrier(xb); }
    }
}

extern "C" void kernel_launch(void* const* d_in, const int* in_sizes, int n_in, void* d_out, int out_size, void* d_ws, size_t ws_size, hipStream_t stream) {
    if (ws_size < WS_NEED) { fprintf(stderr, "workspace too small: %zu < %zu\n", ws_size, (size_t)WS_NEED); return; }
    static int grid_blocks = 0;
    if (!grid_blocks) {
        (void)hipFuncSetAttribute((const void*)mega, hipFuncAttributeMaxDynamicSharedMemorySize, LDS_BYTES);
        int dev = 0, cus = 0, per_cu = 0;
        (void)hipGetDevice(&dev);
        (void)hipDeviceGetAttribute(&cus, hipDeviceAttributeMultiprocessorCount, dev);
        (void)hipOccupancyMaxActiveBlocksPerMultiprocessor(&per_cu, mega, 512, LDS_BYTES);
        if (per_cu < 1) per_cu = 1;
        grid_blocks = cus;
    }
    Params p{};
    for (int i = 0; i < 41; ++i) p.in[i] = (const float*)d_in[i];
    p.out = (float*)d_out; p.ws = (unsigned char*)d_ws;
    void* args[] = {&p};
    (void)hipMemsetAsync((unsigned char*)d_ws + OFF_BAR, 0, 3456 * 4, stream);
    hipError_t e = hipLaunchCooperativeKernel((void*)mega, dim3(grid_blocks), dim3(512), args, LDS_BYTES, stream);
    if (e != hipSuccess) fprintf(stderr, "cooperative launch failed: %s (grid %d)\n", hipGetErrorString(e), grid_blocks);
}
```
